# Optimizing an MI355X kernel written in HIP

```python
import math
import jax, jax.numpy as jnp
from jax import lax
import numpy as np

D_MODEL = 2048
BATCH = 2
SEQ = 4096
DEPTH = 1

D_MIX = D_MODEL
DA_WIDTH = D_MIX // 2
DA_HEADS = 8
DA_V_DIM = DA_WIDTH // DA_HEADS
DA_HEAD_DIM = DA_V_DIM // 2
HG_WIDTH = D_MIX - DA_WIDTH
HG_HEADS = 8
HG_V_DIM = HG_WIDTH // HG_HEADS
HG_K_DIM = 128
HG_KEY_WIDTH = HG_HEADS * HG_K_DIM
HG_CHUNK = 64
SPLIT_SIZES = (DA_WIDTH, DA_WIDTH, DA_WIDTH, HG_KEY_WIDTH, HG_KEY_WIDTH, HG_WIDTH, HG_WIDTH)
D_IN = sum(SPLIT_SIZES)
Q_BLOCK = 128
NUM_BUCKETS = 32
MAX_DISTANCE = 128
N_MEM = 256
MEM_HEADS = 4
MEM_HEAD_DIM = D_MODEL // MEM_HEADS
D_FF = 5632
CONV_WIDTH = 3
EPS = 1e-6

kernel_name = "hymba_diffattn_hgrn2_convffn_block"


def rmsnorm(x, w):
    xf = x.astype(jnp.float32)
    y = xf * lax.rsqrt(jnp.mean(xf * xf, axis=-1, keepdims=True) + EPS)
    return (y * w.astype(jnp.float32)).astype(x.dtype)


def t5_bucket(rel):
    n = jnp.maximum(rel, 0)
    max_exact = NUM_BUCKETS // 2
    nf = jnp.maximum(n, 1).astype(jnp.float32)
    large = max_exact + (jnp.log(nf / max_exact) / math.log(MAX_DISTANCE / max_exact)
                         * (NUM_BUCKETS - max_exact)).astype(jnp.int32)
    large = jnp.minimum(large, NUM_BUCKETS - 1)
    return jnp.where(n < max_exact, n, large)


def diff_attention(q, k, v, lam, bias_table):
    B, S = q.shape[0], q.shape[1]
    nb = S // Q_BLOCK
    scale = DA_HEAD_DIM ** -0.5
    qb = q.reshape(B, nb, Q_BLOCK, DA_HEADS, 2, DA_HEAD_DIM).transpose(1, 0, 3, 4, 2, 5)
    kt = k.transpose(0, 2, 3, 1, 4)
    vt = v.transpose(0, 2, 1, 3)
    kpos = jnp.arange(S)

    def block(args):
        i, qi = args
        qpos = i * Q_BLOCK + jnp.arange(Q_BLOCK)
        rel = qpos[:, None] - kpos[None, :]
        bias = bias_table[t5_bucket(rel)].transpose(2, 0, 1).astype(jnp.float32)
        logits = jnp.einsum('bhmqd,bhmkd->bhmqk', qi, kt).astype(jnp.float32) * scale
        logits = logits + bias[None, :, None]
        logits = jnp.where(rel >= 0, logits, -1e30)
        p = jax.nn.softmax(logits, axis=-1)
        a = p[:, :, 0] - lam * p[:, :, 1]
        return jnp.einsum('bhqk,bhkv->bhqv', a.astype(v.dtype), vt)

    out = lax.map(block, (jnp.arange(nb), qb))
    return out.transpose(1, 0, 3, 2, 4).reshape(B, S, DA_HEADS, DA_V_DIM)


def hgrn2(q, fz, i, lb):
    B, S = q.shape[0], q.shape[1]
    nc = S // HG_CHUNK
    f32 = jnp.float32
    f = lb + (1.0 - lb) * jax.nn.sigmoid(fz.astype(f32))
    log_f = jnp.log(f)
    kk = 1.0 - f

    def to_chunks(t):
        return t.astype(f32).reshape(B, nc, HG_CHUNK, HG_HEADS, t.shape[-1]).transpose(1, 0, 3, 2, 4)

    qc, kc, vc, gc = to_chunks(q), to_chunks(kk), to_chunks(i), to_chunks(log_f)
    causal = jnp.tril(jnp.ones((HG_CHUNK, HG_CHUNK), dtype=bool))[:, :, None]

    def step(state, inp):
        q_c, k_c, v_c, g_c = inp
        G = jnp.cumsum(g_c, axis=2)
        o_inter = jnp.einsum('bhck,bhkv->bhcv', q_c * jnp.exp(G), state)
        diff = G[:, :, :, None, :] - G[:, :, None, :, :]
        decay = jnp.where(causal, jnp.exp(jnp.where(causal, diff, 0.0)), 0.0)
        a = jnp.einsum('bhtk,bhsk,bhtsk->bhts', q_c, k_c, decay)
        o_intra = jnp.einsum('bhts,bhsv->bhtv', a, v_c)
        g_last = G[:, :, -1]
        k_dec = k_c * jnp.exp(g_last[:, :, None, :] - G)
        new_state = jnp.exp(g_last)[..., None] * state + jnp.einsum('bhsk,bhsv->bhkv', k_dec, v_c)
        return new_state, o_inter + o_intra

    s0 = jnp.zeros((B, HG_HEADS, HG_K_DIM, HG_V_DIM), f32)
    _, o = lax.scan(step, s0, (qc, kc, vc, gc))
    return o.transpose(1, 0, 3, 2, 4).reshape(B, S, HG_HEADS, HG_V_DIM).astype(i.dtype)


def causal_dwconv(u, w, b):
    S = u.shape[1]
    up = jnp.pad(u, ((0, 0), (CONV_WIDTH - 1, 0), (0, 0)))
    return sum(w[j] * up[:, j:j + S] for j in range(CONV_WIDTH)) + b


def split_points():
    pts, acc = [], 0
    for s in SPLIT_SIZES[:-1]:
        acc += s
        pts.append(acc)
    return pts


def setup_inputs(seed: int = 0) -> dict:
    key = jax.random.key(seed)
    ks = jax.random.split(key, 24)
    f32 = jnp.float32

    def nrm(k, shape, scale):
        return jax.random.normal(k, shape, f32) * scale

    def gain(k, shape):
        return 1.0 + 0.1 * jax.random.normal(k, shape, f32)

    L = DEPTH
    return {
        "x": nrm(ks[0], (BATCH, SEQ, D_MODEL), 1.0),
        "mem": nrm(ks[1], (BATCH, N_MEM, D_MODEL), 1.0),
        "w_in": nrm(ks[2], (L, D_MODEL, D_IN), D_MODEL ** -0.5),
        "w_out": nrm(ks[3], (L, D_MIX, D_MODEL), D_MIX ** -0.5),
        "norm_mix_w": gain(ks[4], (L, D_MODEL)),
        "lam_q1": nrm(ks[5], (L, DA_HEAD_DIM), 0.1),
        "lam_k1": nrm(ks[6], (L, DA_HEAD_DIM), 0.1),
        "lam_q2": nrm(ks[7], (L, DA_HEAD_DIM), 0.1),
        "lam_k2": nrm(ks[8], (L, DA_HEAD_DIM), 0.1),
        "da_subln_w": gain(ks[9], (L, DA_V_DIM)),
        "hg_lb_raw": nrm(ks[10], (L + 1, HG_KEY_WIDTH), 0.5),
        "hg_norm_w": gain(ks[11], (L, HG_V_DIM)),
        "rel_bias": nrm(ks[12], (NUM_BUCKETS, DA_HEADS), 0.5),
        "norm_mem_w": gain(ks[13], (L, D_MODEL)),
        "mem_kv_norm_w": gain(ks[14], (L, D_MODEL)),
        "w_mq": nrm(ks[15], (L, D_MODEL, D_MODEL), D_MODEL ** -0.5),
        "w_mkv": nrm(ks[16], (L, D_MODEL, 2 * D_MODEL), D_MODEL ** -0.5),
        "w_mo": nrm(ks[17], (L, D_MODEL, D_MODEL), D_MODEL ** -0.5),
        "norm_ffn_w": gain(ks[18], (L, D_MODEL)),
        "w_up": nrm(ks[19], (L, D_MODEL, 2 * D_FF), D_MODEL ** -0.5),
        "conv_w": nrm(ks[20], (L, CONV_WIDTH, 2 * D_FF), CONV_WIDTH ** -0.5),
        "conv_b": nrm(ks[21], (L, 2 * D_FF), 0.02),
        "w_down": nrm(ks[22], (L, D_FF, D_MODEL), D_FF ** -0.5),
        "final_norm_w": gain(ks[23], (D_MODEL,)),
    }


def reference(x, mem, w_in, w_out, norm_mix_w, lam_q1, lam_k1, lam_q2, lam_k2, da_subln_w,
              hg_lb_raw, hg_norm_w, rel_bias, norm_mem_w, mem_kv_norm_w, w_mq, w_mkv, w_mo,
              norm_ffn_w, w_up, conv_w, conv_b, w_down, final_norm_w):
    B, S, _ = x.shape
    f32 = jnp.float32
    lb_all = jnp.cumsum(jax.nn.softmax(hg_lb_raw.astype(f32), axis=0), axis=0)
    pts = split_points()
    for layer in range(DEPTH):
        h = rmsnorm(x, norm_mix_w[layer])
        proj = h @ w_in[layer]
        da_q, da_k, da_v, hg_q, hg_f, hg_i, hg_g = jnp.split(proj, pts, axis=-1)

        lam_init = 0.8 - 0.6 * math.exp(-0.3 * layer)
        lam = (jnp.exp(jnp.sum(lam_q1[layer].astype(f32) * lam_k1[layer].astype(f32)))
               - jnp.exp(jnp.sum(lam_q2[layer].astype(f32) * lam_k2[layer].astype(f32)))
               + lam_init)
        da_o = diff_attention(da_q.reshape(B, S, DA_HEADS, 2, DA_HEAD_DIM),
                              da_k.reshape(B, S, DA_HEADS, 2, DA_HEAD_DIM),
                              da_v.reshape(B, S, DA_HEADS, DA_V_DIM), lam, rel_bias)
        da_o = rmsnorm(da_o, da_subln_w[layer]) * (1.0 - lam_init)

        lb = lb_all[layer].reshape(HG_HEADS, HG_K_DIM)
        hg_o = hgrn2(hg_q.reshape(B, S, HG_HEADS, HG_K_DIM),
                     hg_f.reshape(B, S, HG_HEADS, HG_K_DIM),
                     hg_i.reshape(B, S, HG_HEADS, HG_V_DIM), lb)
        hg_o = rmsnorm(hg_o, hg_norm_w[layer]) * jax.nn.silu(hg_g.reshape(B, S, HG_HEADS, HG_V_DIM))

        mix = jnp.concatenate([da_o.reshape(B, S, DA_WIDTH), hg_o.reshape(B, S, HG_WIDTH)], axis=-1)
        x = x + mix @ w_out[layer]

        hq = rmsnorm(x, norm_mem_w[layer])
        mk = rmsnorm(mem, mem_kv_norm_w[layer])
        mq = (hq @ w_mq[layer]).reshape(B, S, MEM_HEADS, MEM_HEAD_DIM)
        m_k, m_v = jnp.split(mk @ w_mkv[layer], 2, axis=-1)
        m_k = m_k.reshape(B, N_MEM, MEM_HEADS, MEM_HEAD_DIM)
        m_v = m_v.reshape(B, N_MEM, MEM_HEADS, MEM_HEAD_DIM)
        m_logits = jnp.einsum('bqhd,bkhd->bhqk', mq, m_k).astype(f32) * (MEM_HEAD_DIM ** -0.5)
        m_p = jax.nn.softmax(m_logits, axis=-1).astype(x.dtype)
        m_o = jnp.einsum('bhqk,bkhd->bqhd', m_p, m_v).reshape(B, S, D_MODEL)
        x = x + m_o @ w_mo[layer]

        hf = rmsnorm(x, norm_ffn_w[layer])
        u = causal_dwconv(hf @ w_up[layer], conv_w[layer], conv_b[layer])
        a, b = jnp.split(u, 2, axis=-1)
        x = x + (jax.nn.silu(a) * b) @ w_down[layer]
    return rmsnorm(x, final_norm_w)
```

```cpp
#include <hip/hip_runtime.h>
#include <cstdint>
#include <cstdio>

#ifndef MK_N_LAUNCHES
#define MK_N_LAUNCHES 1
#endif

#define LAS __attribute__((address_space(3)))
#define GAS __attribute__((address_space(1)))
typedef unsigned short bf16_t;
typedef short bf16x8 __attribute__((ext_vector_type(8)));
typedef short s16x4 __attribute__((ext_vector_type(4)));
typedef float f32x2 __attribute__((ext_vector_type(2)));
typedef float f32x4 __attribute__((ext_vector_type(4)));
typedef float f32x16 __attribute__((ext_vector_type(16)));
typedef unsigned u32x2 __attribute__((ext_vector_type(2)));
typedef unsigned u32x4 __attribute__((ext_vector_type(4)));
typedef GAS unsigned gu32;

constexpr int BATCH = 2, SEQ = 4096, DM = 2048, MROWS = BATCH * SEQ;
constexpr int DIN = 7168, DFF = 5632, NMEM = 256;
constexpr float EPS = 1e-6f;
constexpr float LOG2E = 1.4426950408889634f;
constexpr float C2_DA = 0.125f * LOG2E;
constexpr float C2_MEM = 0.04419417382415922f * LOG2E;
constexpr int NWAVES = 8, NTHREADS = 512;

constexpr size_t MiB = 1u << 20;
constexpr size_t WS_CTL = 0, CTL_ZERO_BYTES = 1 * MiB;
constexpr size_t WS_RSS1 = 1 * MiB, WS_RSS2 = WS_RSS1 + 256 * 1024, WS_RSS3 = WS_RSS2 + 256 * 1024;
constexpr size_t WS_GLAST = 2 * MiB;
constexpr size_t WS_WIN = 4 * MiB, WS_WOUT = 32 * MiB, WS_WMQ = 40 * MiB, WS_WMKV = 48 * MiB, WS_WMO = 64 * MiB, WS_WUP = 72 * MiB, WS_WDOWN = 116 * MiB;
constexpr size_t WS_KVMEM = 138 * MiB, WS_WKT = 142 * MiB, WS_VWT = 150 * MiB, WS_MK = 158 * MiB;
constexpr size_t WS_A1 = 160 * MiB;
constexpr size_t WS_A2 = 192 * MiB;
constexpr size_t WS_A3 = 240 * MiB;
constexpr size_t WS_A4 = 288 * MiB;
constexpr size_t WS_G = 192 * MiB;
constexpr size_t WS_Y4 = 280 * MiB;
constexpr size_t WS_END = 320 * MiB;
constexpr size_t OUT_SLOC = 0, OUT_O = 32 * MiB;
constexpr size_t SEG = (size_t)MROWS * 1024;

constexpr int CW_BAR = 4096;

constexpr int RING_BYTES = 131072, SPARE_OFF = RING_BYTES, SPARE_BYTES = 12288, MISC_OFF = SPARE_OFF + SPARE_BYTES;
constexpr int LDS_BYTES = 147456;

#define RLX_AGENT __ATOMIC_RELAXED, __HIP_MEMORY_SCOPE_AGENT
#define LDS_WAIT() asm volatile("s_waitcnt lgkmcnt(0)" ::: "memory")
#define VM_WAIT() asm volatile("s_waitcnt vmcnt(0)" ::: "memory")
typedef __bf16 bf16x2_t __attribute__((ext_vector_type(2)));
__device__ __forceinline__ unsigned pk2(float lo, float hi) { f32x2 v = {lo, hi}; bf16x2_t b = __builtin_convertvector(v, bf16x2_t); return __builtin_bit_cast(unsigned, b); }
__device__ __forceinline__ float bf2f(unsigned short b) { return __builtin_bit_cast(float, (unsigned)b << 16); }
__device__ __forceinline__ float bflo(unsigned w) { return __builtin_bit_cast(float, w << 16); }
__device__ __forceinline__ float bfhi(unsigned w) { return __builtin_bit_cast(float, w & 0xffff0000u); }
__device__ __forceinline__ float fexp2(float x) { return __builtin_amdgcn_exp2f(x); }
__device__ __forceinline__ float fexp(float x) { return __builtin_amdgcn_exp2f(x * LOG2E); }
__device__ __forceinline__ float frcp(float x) { return __builtin_amdgcn_rcpf(x); }
__device__ __forceinline__ float wave_sum(float v) {
#pragma unroll
    for (int o = 1; o < 64; o <<= 1) v += __shfl_xor(v, o);
    return v;
}
__device__ __forceinline__ int crow(int r, int hi) { return (r & 3) + 8 * (r >> 2) + 4 * hi; }
__device__ __forceinline__ s16x4 vtr(const LAS unsigned char* p) {
    typedef short v4i16_t __attribute__((ext_vector_type(4)));
    return __builtin_bit_cast(s16x4, __builtin_amdgcn_ds_read_tr16_b64_v4i16((LAS v4i16_t*)p));
}
__device__ __forceinline__ bf16x8 cat8(s16x4 a, s16x4 b) { return (bf16x8){a[0], a[1], a[2], a[3], b[0], b[1], b[2], b[3]}; }
__device__ __forceinline__ bf16x8 pack8(const f32x16& p, int b) {
    u32x4 w = {pk2(p[b], p[b + 1]), pk2(p[b + 2], p[b + 3]), pk2(p[b + 4], p[b + 5]), pk2(p[b + 6], p[b + 7])};
    return __builtin_bit_cast(bf16x8, w);
}
__device__ __forceinline__ void glds16(const void* g, LAS unsigned char* l) {
    __builtin_amdgcn_global_load_lds((const GAS unsigned*)g, (LAS unsigned*)l, 16, 0, 0);
}

__device__ const unsigned char T5_BUCKET[132] = {0, 1, 2, 3, 4, 5, 6, 7, 8, 9, 10, 11, 12, 13, 14, 15, 16, 16, 16, 17, 17, 18, 18, 18, 19, 19, 19, 20, 20, 20, 20, 21, 21, 21, 21, 22, 22, 22, 22, 22, 23, 23, 23, 23, 23, 23, 24, 24, 24, 24, 24, 24, 25, 25, 25, 25, 25, 25, 25, 26, 26, 26, 26, 26, 26, 26, 26, 27, 27, 27, 27, 27, 27, 27, 27, 27, 27, 28, 28, 28, 28, 28, 28, 28, 28, 28, 28, 29, 29, 29, 29, 29, 29, 29, 29, 29, 29, 29, 29, 30, 30, 30, 30, 30, 30, 30, 30, 30, 30, 30, 30, 30, 30, 31, 31, 31, 31, 31, 31, 31, 31, 31, 31, 31, 31, 31, 31, 31, 31, 31, 31, 31};

namespace pg8 {
constexpr int BM = 256, BK = 64, HALF = 128, HTB = HALF * BK * 2, STAGE_BYTES = 8 * HTB, NXCD = 8, WGM = 8;
__host__ __device__ __forceinline__ int lds_byte(int r, int c) { const int st = (r >> 4) * 2 + (c >> 5), rr = r & 15, cc = c & 31, ob = rr * 64 + cc * 2; return st * 1024 + (ob ^ (((ob >> 9) & 1) << 5)); }
__host__ __device__ __forceinline__ void stage_rc(int b, int& R, int& C) { const int st = b / 1024, sb = b % 1024, swz = sb ^ (((sb >> 9) & 1) << 5); R = (st >> 1) * 16 + swz / 64; C = (st & 1) * 32 + (swz % 64) / 2; }
__host__ __device__ __forceinline__ int perm32(int rho) { const int n = rho >> 4, i = rho & 15; return 8 * (i >> 2) + 4 * n + (i & 3); }

struct Unit { int pm, pn, zb, zh; };
struct Gemm { const bf16_t* A; const bf16_t* Bt; int lda, ldb, K; long a_zb, a_zh, b_zb, b_zh, b_tile, b_half, b_batch; };
struct Order {
    int nM, nN, total, G, c;
    __device__ void init(int nM_, int nN_, int nZ_, int G_, int c_) { nM = nM_; nN = nN_; total = nM_ * nN_ * nZ_; G = G_; c = c_; }
    __device__ __forceinline__ bool next(int i, Unit& u) const {
        const long L = (long)i * G + c; if (L >= total) return false;
        int wgid = (int)L; { const int q = total / NXCD, r = total % NXCD, xcd = wgid % NXCD, off = wgid / NXCD; wgid = (xcd < r ? xcd * (q + 1) : r * (q + 1) + (xcd - r) * q) + off; }
        const int per = nM * nN, z = wgid / per, w = wgid % per;
        const int nig = WGM * nN, gid = w / nig, fm = gid * WGM, gsz = (nM - fm) < WGM ? (nM - fm) : WGM;
        u.pm = fm + ((w % nig) % gsz); u.pn = (w % nig) / gsz; u.zb = z >> 2; u.zh = z & 3; return true;
    }
};
__device__ __forceinline__ const char* a_ptr(const Gemm& g, const Unit& u) { return (const char*)(g.A + u.zb * g.a_zb + u.zh * g.a_zh + (long)u.pm * BM * g.lda); }
__device__ __forceinline__ const char* b_ptr(const Gemm& g, const Unit& u) { return (const char*)(g.Bt + u.zb * g.b_zb + u.zh * g.b_zh + (long)u.pn * g.b_tile + (long)(u.pm >> 4) * g.b_batch); }

template <class Epi, bool ALIGN_EPI>
__device__ __forceinline__ void gemm_phase(LAS unsigned char* lds, const Gemm& g, const Order& S, const Epi& E) {
    int tid_ = threadIdx.x; asm volatile("" : "+v"(tid_));
    const int tid = tid_, wid = __builtin_amdgcn_readfirstlane(tid >> 6), lane = tid & 63, wr = wid >> 2, wc = wid & 3, fr = lane & 15, fq = lane >> 4;
    const int K = g.K, nt = K / BK;
    unsigned voffA[2], voffB[2];
#pragma unroll
    for (int i = 0; i < 2; ++i) { int R, C; stage_rc(tid * 16 + i * 8192, R, C); const int Rb = Epi::PERM ? ((R & ~31) + perm32(R & 31)) : R;
        voffA[i] = (unsigned)(R * g.lda + C) * 2u; voffB[i] = (unsigned)(Rb * g.ldb + C) * 2u; }
    const size_t kstep = (size_t)(BK * 2);
    const size_t hstepA = (size_t)HALF * g.lda * 2, hstepB = (size_t)g.b_half * 2;
    const unsigned ldsw = (unsigned)wid * 1024u;
    const int aoff = lds_byte(wr * 64 + fr, fq * 8), boff = lds_byte(wc * 32 + fr, fq * 8);
#define PG8_SA(b, h) (((b) * 2 + (h)) * HTB)
#define PG8_SB(b, h) ((4 + (b) * 2 + (h)) * HTB)
#define PG8_STAGE(bufoff, gbase, voff) do { _Pragma("unroll") for (int _i = 0; _i < 2; ++_i) \
        __builtin_amdgcn_global_load_lds((const GAS unsigned*)((const char*)(gbase) + (voff)[_i]), (LAS unsigned*)(lds + (bufoff) + ldsw + _i * 8192), 16, 0, 0); } while (0)
#define PG8_LDA(dst, b, h) do { _Pragma("unroll") for (int m = 0; m < 4; ++m) _Pragma("unroll") for (int k = 0; k < 2; ++k) dst[m][k] = *(const LAS bf16x8*)(lds + PG8_SA(b, h) + aoff + m * 2048 + k * 1024); } while (0)
#define PG8_LDB(dst, b, h) do { _Pragma("unroll") for (int n = 0; n < 2; ++n) _Pragma("unroll") for (int k = 0; k < 2; ++k) dst[n][k] = *(const LAS bf16x8*)(lds + PG8_SB(b, h) + boff + n * 2048 + k * 1024); } while (0)
#define PG8_MMA(ai, bj, At, Bt) do { __builtin_amdgcn_s_setprio(1); _Pragma("unroll") for (int m = 0; m < 4; ++m) _Pragma("unroll") for (int n = 0; n < 2; ++n) _Pragma("unroll") for (int k = 0; k < 2; ++k) \
        acc[ai][bj][m][n] = __builtin_amdgcn_mfma_f32_16x16x32_bf16(Bt[n][k], At[m][k], acc[ai][bj][m][n], 0, 0, 0); __builtin_amdgcn_s_setprio(0); } while (0)
#define PG8_WAIT_V(n) asm volatile("s_waitcnt vmcnt(" #n ")" ::: "memory")
#define PG8_WAIT_L(n) asm volatile("s_waitcnt lgkmcnt(" #n ")" ::: "memory")
#define PG8_BAR __builtin_amdgcn_s_barrier()
#define PG8_SCHED __builtin_amdgcn_sched_barrier(0)
    Unit cur, nxt; int ui = 0;
    if (!S.next(0, cur)) return;
    f32x4 acc[2][2][4][2];
#pragma unroll
    for (int a = 0; a < 2; ++a)
#pragma unroll
        for (int b = 0; b < 2; ++b)
#pragma unroll
            for (int m = 0; m < 4; ++m)
#pragma unroll
                for (int n = 0; n < 2; ++n) acc[a][b][m][n] = (f32x4){0.f, 0.f, 0.f, 0.f};
    bf16x8 At[4][2], B0[2][2], B1[2][2];
    const char* cA = a_ptr(g, cur); const char* cB = b_ptr(g, cur);
    PG8_STAGE(PG8_SB(0, 0), cB, voffB); PG8_STAGE(PG8_SB(0, 1), cB + hstepB, voffB); PG8_STAGE(PG8_SA(0, 0), cA, voffA); PG8_STAGE(PG8_SA(0, 1), cA + hstepA, voffA);
    if (wr == 1) PG8_BAR;
    PG8_WAIT_V(2); PG8_BAR;
    PG8_STAGE(PG8_SB(1, 0), cB + kstep, voffB); PG8_STAGE(PG8_SA(1, 0), cA + kstep, voffA); PG8_STAGE(PG8_SB(1, 1), cB + hstepB + kstep, voffB);
    PG8_WAIT_V(6); PG8_BAR;
    for (;;) {
        const bool has_next = S.next(ui + 1, nxt);
        const char* nA = has_next ? a_ptr(g, nxt) : cA; const char* nB = has_next ? b_ptr(g, nxt) : cB;
        for (int t = 0; t < nt; t += 2) {
            const bool last = (t == nt - 2);
            const char* a1 = cA + (size_t)(t + 1) * kstep;
            const char* a2 = last ? nA : cA + (size_t)(t + 2) * kstep; const char* b2 = last ? nB : cB + (size_t)(t + 2) * kstep;
            const char* a3 = a2 + kstep; const char* b3 = b2 + kstep;
            PG8_LDB(B0, 0, 0); PG8_LDB(B1, 0, 1); PG8_SCHED; PG8_LDA(At, 0, 0); PG8_STAGE(PG8_SA(1, 1), a1 + hstepA, voffA);
            PG8_WAIT_V(8); PG8_WAIT_L(0); PG8_BAR; PG8_MMA(0, 0, At, B0); PG8_MMA(0, 1, At, B1); PG8_BAR; PG8_SCHED;
            PG8_LDA(At, 0, 1); PG8_STAGE(PG8_SB(0, 0), b2, voffB); PG8_STAGE(PG8_SB(0, 1), b2 + hstepB, voffB); PG8_STAGE(PG8_SA(0, 0), a2, voffA);
            PG8_WAIT_V(8); PG8_WAIT_L(0); PG8_BAR; PG8_MMA(1, 0, At, B0); PG8_MMA(1, 1, At, B1); PG8_BAR; PG8_SCHED;
            PG8_LDB(B0, 1, 0); PG8_LDB(B1, 1, 1); PG8_SCHED; PG8_LDA(At, 1, 0); PG8_STAGE(PG8_SA(0, 1), a2 + hstepA, voffA);
            PG8_WAIT_V(8); PG8_WAIT_L(0); PG8_BAR; PG8_MMA(0, 0, At, B0); PG8_MMA(0, 1, At, B1); PG8_BAR; PG8_SCHED;
            PG8_LDA(At, 1, 1); PG8_STAGE(PG8_SB(1, 0), b3, voffB); PG8_STAGE(PG8_SB(1, 1), b3 + hstepB, voffB); PG8_STAGE(PG8_SA(1, 0), a3, voffA);
            PG8_WAIT_V(8); PG8_WAIT_L(0); PG8_BAR; PG8_MMA(1, 0, At, B0); PG8_MMA(1, 1, At, B1); PG8_BAR; PG8_SCHED;
        }
        if constexpr (ALIGN_EPI) { if (wr == 0) PG8_BAR; }
        PG8_SCHED;
        if constexpr (!Epi::AFTER_DRAIN) { E(acc, cur, wr, wc, fr, fq, lds, wid, lane); }
        PG8_SCHED;
        if (!has_next) break;
#pragma unroll
        for (int a = 0; a < 2; ++a)
#pragma unroll
            for (int b = 0; b < 2; ++b)
#pragma unroll
                for (int m = 0; m < 4; ++m)
#pragma unroll
                    for (int n = 0; n < 2; ++n) acc[a][b][m][n] = (f32x4){0.f, 0.f, 0.f, 0.f};
        cur = nxt; cA = nA; cB = nB; ++ui;
        if constexpr (ALIGN_EPI) { if (wr == 1) PG8_BAR; }
    }
    PG8_WAIT_V(0);
    if constexpr (!ALIGN_EPI) { if (wr == 0) PG8_BAR; }
    PG8_BAR;
    if constexpr (Epi::AFTER_DRAIN) { E(acc, cur, wr, wc, fr, fq, lds, wid, lane); }
#undef PG8_SA
#undef PG8_SB
#undef PG8_STAGE
#undef PG8_LDA
#undef PG8_LDB
#undef PG8_MMA
#undef PG8_WAIT_V
#undef PG8_WAIT_L
#undef PG8_SCHED
}
#define EPI_BAR() do { asm volatile("s_waitcnt lgkmcnt(0)" ::: "memory"); __builtin_amdgcn_s_barrier(); asm volatile("" ::: "memory"); } while (0)

struct EpiBf16 {
    static constexpr bool PERM = true, AFTER_DRAIN = false;
    bf16_t* O; int ldc; long o_zb, o_zh;
    __device__ __forceinline__ void operator()(const f32x4 (&acc)[2][2][4][2], const Unit& u, int wr, int wc, int fr, int fq, LAS unsigned char*, int, int) const {
        bf16_t* base = O + u.zb * o_zb + u.zh * o_zh;
        const int row0 = u.pm * BM + wr * 64 + fr, col0 = u.pn * BM + wc * 32 + 8 * fq;
#pragma unroll
        for (int ai = 0; ai < 2; ++ai)
#pragma unroll
            for (int m = 0; m < 4; ++m) { bf16_t* rowp = base + (size_t)(row0 + ai * HALF + m * 16) * ldc + col0;
#pragma unroll
                for (int bj = 0; bj < 2; ++bj) { const f32x4 v0 = acc[ai][bj][m][0], v1 = acc[ai][bj][m][1];
                    u32x4 w; w.x = pk2(v0[0], v0[1]); w.y = pk2(v0[2], v0[3]); w.z = pk2(v1[0], v1[1]); w.w = pk2(v1[2], v1[3]);
                    *(u32x4*)(rowp + bj * HALF) = w; } }
    }
};
struct EpiInProj {
    static constexpr bool PERM = true, AFTER_DRAIN = false;
    bf16_t* da; bf16_t* hg; float* logf; const float* lbraw;
    __device__ __forceinline__ void operator()(const f32x4 (&acc)[2][2][4][2], const Unit& u, int wr, int wc, int fr, int fq, LAS unsigned char*, int, int) const {
        const int seg = u.pn >> 2, colt = (u.pn & 3) * BM;
        const int row0 = u.pm * BM + wr * 64 + fr, col0 = colt + wc * 32 + 8 * fq;
        if (seg == 4) {
            float lb[2][8];
#pragma unroll
            for (int bj = 0; bj < 2; ++bj) { const f32x4 r0a = *(const f32x4*)(lbraw + col0 + bj * HALF), r0b = *(const f32x4*)(lbraw + col0 + bj * HALF + 4);
                const f32x4 r1a = *(const f32x4*)(lbraw + 1024 + col0 + bj * HALF), r1b = *(const f32x4*)(lbraw + 1024 + col0 + bj * HALF + 4);
#pragma unroll
                for (int j = 0; j < 4; ++j) { lb[bj][j] = frcp(1.f + fexp(r1a[j] - r0a[j])); lb[bj][4 + j] = frcp(1.f + fexp(r1b[j] - r0b[j])); } }
#pragma unroll
            for (int ai = 0; ai < 2; ++ai)
#pragma unroll
                for (int m = 0; m < 4; ++m) { float* rowp = logf + (size_t)(row0 + ai * HALF + m * 16) * 1024 + col0;
#pragma unroll
                    for (int bj = 0; bj < 2; ++bj)
#pragma unroll
                        for (int n = 0; n < 2; ++n) { const f32x4 v = acc[ai][bj][m][n]; f32x4 o;
#pragma unroll
                            for (int j = 0; j < 4; ++j) { const float l = lb[bj][4 * n + j], sg = frcp(1.f + fexp(-v[j])); o[j] = __builtin_amdgcn_logf(l + (1.f - l) * sg) * 0.6931471805599453f; }
                            *(f32x4*)(rowp + bj * HALF + 4 * n) = o; } }
        } else {
            bf16_t* base = seg < 3 ? da + (size_t)seg * SEG : hg + (size_t)(seg == 3 ? 0 : seg - 4) * SEG;
            const float sc = seg == 0 ? C2_DA : 1.f;
#pragma unroll
            for (int ai = 0; ai < 2; ++ai)
#pragma unroll
                for (int m = 0; m < 4; ++m) { bf16_t* rowp = base + (size_t)(row0 + ai * HALF + m * 16) * 1024 + col0;
#pragma unroll
                    for (int bj = 0; bj < 2; ++bj) { const f32x4 v0 = acc[ai][bj][m][0] * sc, v1 = acc[ai][bj][m][1] * sc;
                        u32x4 w; w.x = pk2(v0[0], v0[1]); w.y = pk2(v0[2], v0[3]); w.z = pk2(v1[0], v1[1]); w.w = pk2(v1[2], v1[3]);
                        *(u32x4*)(rowp + bj * HALF) = w; } }
        }
    }
};
template <bool WRITE_BF16> struct EpiResid {
    static constexpr bool PERM = false, AFTER_DRAIN = true;
    const float* xold; float* xnew; bf16_t* xb; float* rss;
    __device__ __forceinline__ void operator()(f32x4 (&acc)[2][2][4][2], const Unit& u, int wr, int wc, int fr, int fq, LAS unsigned char* lds, int, int) const {
        LAS float* P = (LAS float*)lds;
        const int col0 = u.pn * BM + wc * 32 + 4 * fq;
#pragma unroll
        for (int ai = 0; ai < 2; ++ai)
#pragma unroll
            for (int m = 0; m < 4; ++m) { const int rl = ai * HALF + wr * 64 + m * 16 + fr; const size_t off = (size_t)(u.pm * BM + rl) * DM + col0; float ss = 0.f;
#pragma unroll
                for (int bj = 0; bj < 2; ++bj)
#pragma unroll
                    for (int n = 0; n < 2; ++n) { const f32x4 xo = *(const f32x4*)(xold + off + bj * HALF + n * 16); const f32x4 v = xo + acc[ai][bj][m][n];
                        *(f32x4*)(xnew + off + bj * HALF + n * 16) = v;
                        if (WRITE_BF16) { u32x2 w; w.x = pk2(v[0], v[1]); w.y = pk2(v[2], v[3]); *(u32x2*)(xb + off + bj * HALF + n * 16) = w; }
                        ss += (v[0] * v[0] + v[1] * v[1]) + (v[2] * v[2] + v[3] * v[3]); }
                ss += __shfl_xor(ss, 16); ss += __shfl_xor(ss, 32);
                if (fq == 0) P[rl * 4 + wc] = ss;
                asm volatile("" ::: "memory"); }
        EPI_BAR();
        const int t = threadIdx.x;
        if (t < 256) { const f32x4 p = *(const LAS f32x4*)(P + t * 4); rss[(size_t)(u.pm * BM + t) * 8 + u.pn] = (p[0] + p[1]) + (p[2] + p[3]); }
    }
};
__device__ __forceinline__ float row_rinv(const float* rss, int row) {
    const f32x4 a = *(const f32x4*)(rss + (size_t)row * 8), b = *(const f32x4*)(rss + (size_t)row * 8 + 4);
    const float s = ((a[0] + a[1]) + (a[2] + a[3])) + ((b[0] + b[1]) + (b[2] + b[3]));
    return __builtin_amdgcn_rsqf(s * (1.0f / DM) + EPS);
}
struct EpiSoftmax {
    static constexpr bool PERM = true, AFTER_DRAIN = true;
    const float* rss; bf16_t* Pout;
    __device__ __forceinline__ void operator()(f32x4 (&acc)[2][2][4][2], const Unit& u, int wr, int wc, int fr, int fq, LAS unsigned char* lds, int, int) const {
        LAS float* Pm = (LAS float*)lds; LAS float* Ps = (LAS float*)(lds + 4096);
#pragma unroll
        for (int ai = 0; ai < 2; ++ai)
#pragma unroll
            for (int m = 0; m < 4; ++m) { const int rl = ai * HALF + wr * 64 + m * 16 + fr; const float ri = row_rinv(rss, u.pm * BM + rl); float mx = -INFINITY;
#pragma unroll
                for (int bj = 0; bj < 2; ++bj)
#pragma unroll
                    for (int n = 0; n < 2; ++n) { f32x4 v = acc[ai][bj][m][n] * ri; acc[ai][bj][m][n] = v; mx = fmaxf(mx, fmaxf(fmaxf(v[0], v[1]), fmaxf(v[2], v[3]))); }
                mx = fmaxf(mx, __shfl_xor(mx, 16)); mx = fmaxf(mx, __shfl_xor(mx, 32));
                if (fq == 0) Pm[rl * 4 + wc] = mx; }
        EPI_BAR();
#pragma unroll
        for (int ai = 0; ai < 2; ++ai)
#pragma unroll
            for (int m = 0; m < 4; ++m) { const int rl = ai * HALF + wr * 64 + m * 16 + fr; const f32x4 pm4 = *(const LAS f32x4*)(Pm + rl * 4);
                const float mx = fmaxf(fmaxf(pm4[0], pm4[1]), fmaxf(pm4[2], pm4[3])); float sm = 0.f;
#pragma unroll
                for (int bj = 0; bj < 2; ++bj)
#pragma unroll
                    for (int n = 0; n < 2; ++n) { f32x4 v = acc[ai][bj][m][n];
#pragma unroll
                        for (int j = 0; j < 4; ++j) { v[j] = fexp2(v[j] - mx); sm += v[j]; }
                        acc[ai][bj][m][n] = v; }
                sm += __shfl_xor(sm, 16); sm += __shfl_xor(sm, 32);
                if (fq == 0) Ps[rl * 4 + wc] = sm; }
        EPI_BAR();
        const int col0 = u.pn * BM + wc * 32 + 8 * fq;
#pragma unroll
        for (int ai = 0; ai < 2; ++ai)
#pragma unroll
            for (int m = 0; m < 4; ++m) { const int rl = ai * HALF + wr * 64 + m * 16 + fr; const f32x4 ps4 = *(const LAS f32x4*)(Ps + rl * 4);
                const float il = frcp((ps4[0] + ps4[1]) + (ps4[2] + ps4[3])); bf16_t* rowp = Pout + (size_t)(u.pm * BM + rl) * 1024 + col0;
#pragma unroll
                for (int bj = 0; bj < 2; ++bj) { const f32x4 v0 = acc[ai][bj][m][0] * il, v1 = acc[ai][bj][m][1] * il;
                    u32x4 w; w.x = pk2(v0[0], v0[1]); w.y = pk2(v0[2], v0[3]); w.z = pk2(v1[0], v1[1]); w.w = pk2(v1[2], v1[3]);
                    *(u32x4*)(rowp + bj * HALF) = w; } }
    }
};
template <int CTRL> __device__ __forceinline__ unsigned dpp_upd(unsigned old, unsigned src) {
    return (unsigned)__builtin_amdgcn_update_dpp((int)old, (int)src, CTRL, 0xF, 0xF, false);
}
template <int CTRL> __device__ __forceinline__ unsigned dpp_rot(unsigned src) { return (unsigned)__builtin_amdgcn_mov_dpp((int)src, CTRL, 0xF, 0xF, true); }
struct EpiUp {
    static constexpr bool PERM = true, AFTER_DRAIN = false;
    const float* rss; const float* cw; const float* cb; bf16_t* G; bf16_t* Y4;
    __device__ __forceinline__ void operator()(f32x4 (&acc)[2][2][4][2], const Unit& u, int wr, int wc, int fr, int fq, LAS unsigned char* lds, int wid, int lane) const {
        LAS unsigned* HX = (LAS unsigned*)(lds + SPARE_OFF);
        { int l_; asm volatile("v_mbcnt_lo_u32_b32 %0, -1, 0\n\tv_mbcnt_hi_u32_b32 %0, -1, %0" : "=v"(l_)); fr = l_ & 15; fq = l_ >> 4; }
        u32x2 yp[2][2][4][2];
#pragma unroll
        for (int ai = 0; ai < 2; ++ai)
#pragma unroll
            for (int m = 0; m < 4; ++m) { const float ri = row_rinv(rss, u.pm * BM + ai * HALF + wr * 64 + m * 16 + fr);
#pragma unroll
                for (int bj = 0; bj < 2; ++bj)
#pragma unroll
                    for (int n = 0; n < 2; ++n) { const f32x4 v = acc[ai][bj][m][n] * ri; yp[ai][bj][m][n] = (u32x2){pk2(v[0], v[1]), pk2(v[2], v[3])}; }
                asm volatile("" : "+v"(yp[ai][0][m][0]), "+v"(yp[ai][0][m][1]), "+v"(yp[ai][1][m][0]), "+v"(yp[ai][1][m][1]) :: "memory"); }
        const int clw = 4 * fq;
        const int colg = u.pn * HALF + wc * 32 + 8 * fq;
        if (fr >= 14) {
#pragma unroll
            for (int ai = 0; ai < 2; ++ai)
#pragma unroll
                for (int bj = 0; bj < 2; ++bj) *(LAS u32x4*)(HX + ((wid * 2 + ai) * 2 + (fr - 14)) * 32 + bj * 16 + clw) = (u32x4){yp[ai][bj][3][0].x, yp[ai][bj][3][0].y, yp[ai][bj][3][1].x, yp[ai][bj][3][1].y};
            if (wr == 1) {
#pragma unroll
                for (int bj = 0; bj < 2; ++bj) *(u32x4*)(Y4 + (unsigned)((u.pm * 4 + 2 + (fr - 14)) * (2 * DFF) + bj * DFF + colg)) = (u32x4){yp[1][bj][3][0].x, yp[1][bj][3][0].y, yp[1][bj][3][1].x, yp[1][bj][3][1].y};
            }
        }
        if (fr < 2 && wr == 0) {
#pragma unroll
            for (int bj = 0; bj < 2; ++bj) *(u32x4*)(Y4 + (unsigned)((u.pm * 4 + fr) * (2 * DFF) + bj * DFF + colg)) = (u32x4){yp[0][bj][0][0].x, yp[0][bj][0][0].y, yp[0][bj][0][1].x, yp[0][bj][0][1].y};
        }
        EPI_BAR();
#pragma unroll
        for (int ai = 0; ai < 2; ++ai) {
            const bool tile_top = (ai == 0 && wr == 0);
            const int pw = (wr == 1) ? wc : 4 + wc, pai = (wr == 1) ? ai : 0;
            const LAS unsigned* hp = HX + ((pw * 2 + pai) * 2) * 32;
            u32x4 outw[4];
            int colg_a = colg; asm volatile("" : "+v"(colg_a));
#pragma unroll
            for (int n = 0; n < 2; ++n) {
                float ua[4][4];
#pragma unroll
                for (int bj = 0; bj < 2; ++bj) {
                    const unsigned c = (unsigned)(bj * DFF + colg_a + 4 * n);
                    const f32x4 w0 = *(const f32x4*)(cw + c), w1 = *(const f32x4*)(cw + (2 * DFF + c)), w2 = *(const f32x4*)(cw + (4 * DFF + c)), bb = *(const f32x4*)(cb + c);
                    u32x2 h2 = (u32x2){0u, 0u}, h1 = h2;
                    if (!tile_top) { h2 = *(const LAS u32x2*)(hp + bj * 16 + clw + 2 * n); h1 = *(const LAS u32x2*)(hp + 32 + bj * 16 + clw + 2 * n); }
#pragma unroll
                    for (int m = 0; m < 4; ++m) {
                        float gg[4];
#pragma unroll
                        for (int j2 = 0; j2 < 2; ++j2) {
                            const unsigned x = yp[ai][bj][m][n][j2];
                            unsigned o1, o2;
                            if (m == 0) { o1 = h1[j2]; o2 = (fr == 0) ? h2[j2] : h1[j2]; }
                            else { const unsigned xp = yp[ai][bj][m - 1][n][j2]; o1 = dpp_rot<0x121>(xp); o2 = dpp_rot<0x122>(xp); }
                            const unsigned p1 = dpp_upd<0x111>(o1, x), p2 = dpp_upd<0x112>(o2, x);
                            const float u0 = bb[2 * j2] + w0[2 * j2] * bflo(p2) + w1[2 * j2] * bflo(p1) + w2[2 * j2] * bflo(x);
                            const float u1 = bb[2 * j2 + 1] + w0[2 * j2 + 1] * bfhi(p2) + w1[2 * j2 + 1] * bfhi(p1) + w2[2 * j2 + 1] * bfhi(x);
                            if (bj == 0) { ua[m][2 * j2] = u0; ua[m][2 * j2 + 1] = u1; }
                            else { gg[2 * j2] = ua[m][2 * j2] * frcp(1.f + fexp(-ua[m][2 * j2])) * u0; gg[2 * j2 + 1] = ua[m][2 * j2 + 1] * frcp(1.f + fexp(-ua[m][2 * j2 + 1])) * u1; }
                        }
                        if (bj == 1) { if (n == 0) { outw[m].x = pk2(gg[0], gg[1]); outw[m].y = pk2(gg[2], gg[3]); } else { outw[m].z = pk2(gg[0], gg[1]); outw[m].w = pk2(gg[2], gg[3]); } }
                    }
                    asm volatile("" ::: "memory");
                }
            }
#pragma unroll
            for (int m = 0; m < 4; ++m) *(u32x4*)(G + (unsigned)((u.pm * BM + ai * HALF + wr * 64 + m * 16 + fr) * DFF + colg)) = outw[m];
            asm volatile("" ::: "memory");
        }
    }
};
}

#define XB_TMO      128
#define XB_XCNT(j)  (256  + 64 * (j))
#define XB_XSUB(j)  (1280 + 64 * (j))
#define XB_XGEN(j)  (2304 + 64 * (j))
#define XB_TOP      3328
#define XB_TOPGEN   3392
#define XCD_BAR_WORDS 3456
#define XB_SPIN_CAP (1u << 22)
__device__ __forceinline__ unsigned xb_ld(unsigned* p)              { return __hip_atomic_load(p, __ATOMIC_RELAXED, __HIP_MEMORY_SCOPE_AGENT); }
__device__ __forceinline__ unsigned xb_add(unsigned* p, unsigned v) { return __hip_atomic_fetch_add(p, v, __ATOMIC_RELAXED, __HIP_MEMORY_SCOPE_AGENT); }
__device__ __forceinline__ unsigned xb_xcc_id() { return (unsigned)__builtin_amdgcn_s_getreg((3 << 11) | 20) & 0xFu; }
#define XB_SPIN(cond, bar) do { unsigned _sp = 0; while (cond) { __builtin_amdgcn_s_sleep(1); \
    if ((++_sp & 255u) == 0u) { if (xb_ld(&(bar)[XB_TMO])) break; if (_sp > XB_SPIN_CAP) { atomicAdd(&(bar)[XB_TMO], 1u); break; } } } } while (0)
struct XcdBarrier { unsigned* bar; unsigned x; volatile LAS unsigned* st; };
__device__ __forceinline__ XcdBarrier xcd_barrier_post(unsigned* bar, volatile LAS unsigned* st) {
    XcdBarrier b; b.bar = bar; b.x = xb_xcc_id(); b.st = st;
    if (threadIdx.x == 0) (void)xb_add(&bar[XB_XCNT(b.x)], 1u);
    return b;
}
__device__ __forceinline__ void xcd_barrier_complete(unsigned* bar, unsigned x, unsigned& nloc, unsigned& nx) {
    const unsigned G = gridDim.x * gridDim.y * gridDim.z;
    unsigned sum, cnt, mine, sp = 0u;
    for (;;) {
        sum = 0u; cnt = 0u; mine = 0u;
#pragma unroll
        for (unsigned j = 0; j < 16; ++j) { const unsigned c = xb_ld(&bar[XB_XCNT(j)]); sum += c; cnt += (c > 0u) ? 1u : 0u; mine = (j == x) ? c : mine; }
        if (sum == G) break;
        __builtin_amdgcn_s_sleep(1);
        if ((++sp & 255u) == 0u) { if (xb_ld(&bar[XB_TMO])) break; if (sp > XB_SPIN_CAP) { atomicAdd(&bar[XB_TMO], 1u); break; } }
    }
    nloc = mine > 0u ? mine : 1u; nx = cnt > 0u ? cnt : 1u;
}
__device__ __forceinline__ void xcd_barrier(const XcdBarrier& b) {
    asm volatile("s_waitcnt vmcnt(0)" ::: "memory");
    __syncthreads();
    if (threadIdx.x == 0) {
        unsigned* bar = b.bar;
        __builtin_amdgcn_s_waitcnt(0);
        unsigned nloc = b.st[0], nx = b.st[1];
        if (nloc == 0u) { xcd_barrier_complete(bar, b.x, nloc, nx); b.st[0] = nloc; b.st[1] = nx; }
        const unsigned old = xb_add(&bar[XB_XSUB(b.x)], 1u);
        const unsigned gen = old / nloc;
        if (old + 1u == (gen + 1u) * nloc) {
            __builtin_amdgcn_fence(__ATOMIC_RELEASE, "agent");
            asm volatile("s_waitcnt vmcnt(0)" ::: "memory");
            const unsigned og = xb_add(&bar[XB_TOP], 1u);
            const unsigned tg = og / nx;
            if (og + 1u == (tg + 1u) * nx) xb_add(&bar[XB_TOPGEN], 1u);
            else XB_SPIN(xb_ld(&bar[XB_TOPGEN]) == tg, bar);
            __builtin_amdgcn_fence(__ATOMIC_ACQUIRE, "agent");
            xb_add(&bar[XB_XGEN(b.x)], 1u);
            asm volatile("s_waitcnt vmcnt(0)" ::: "memory");
        } else {
            XB_SPIN(xb_ld(&bar[XB_XGEN(b.x)]) == gen, bar);
            __builtin_amdgcn_fence(__ATOMIC_ACQUIRE, "agent");
            asm volatile("s_waitcnt vmcnt(0)" ::: "memory");
        }
    }
    __syncthreads();
}

struct Args {
    const float *x, *mem, *w_in, *w_out, *norm_mix_w, *lam_q1, *lam_k1, *lam_q2, *lam_k2, *da_subln_w, *hg_lb_raw, *hg_norm_w, *rel_bias, *norm_mem_w, *mem_kv_norm_w,
        *w_mq, *w_mkv, *w_mo, *norm_ffn_w, *w_up, *conv_w, *conv_b, *w_down, *final_norm_w;
    float* out; unsigned char* ws; int ph_lo, ph_hi;
};
struct Ctx { LAS unsigned char* lds; int tid, lane, wave, vcu, G; };

__device__ __forceinline__ Ctx fresh(const Ctx& F0) {
    Ctx F = F0; int t = threadIdx.x; asm volatile("" : "+v"(t)); F.tid = t; F.lane = t & 63; F.wave = __builtin_amdgcn_readfirstlane(t >> 6); return F;
}
__device__ __forceinline__ void cvt_item(const float* W, int K, int N, bf16_t* WT, const float* rs, int item, int lane) {
    const int nblk = N / 32, kb = item / nblk, nb = item % nblk, k0 = 64 * kb, n0 = 32 * nb, c = lane >> 3, nq = lane & 7;
    const float* src = W + (size_t)(k0 + 8 * c) * N + n0 + 4 * nq;
    f32x4 v[8];
#pragma unroll
    for (int i = 0; i < 8; ++i) v[i] = __builtin_nontemporal_load((const f32x4*)(src + (size_t)i * N));
    if (rs) { const f32x4 r0 = *(const f32x4*)(rs + k0 + 8 * c), r1 = *(const f32x4*)(rs + k0 + 8 * c + 4);
#pragma unroll
        for (int i = 0; i < 4; ++i) { v[i] = v[i] * r0[i]; v[4 + i] = v[4 + i] * r1[i]; } }
    bf16_t* dst = WT + (size_t)(n0 + 4 * nq) * K + k0 + 8 * c;
#pragma unroll
    for (int j = 0; j < 4; ++j) { u32x4 o; o.x = pk2(v[0][j], v[1][j]); o.y = pk2(v[2][j], v[3][j]); o.z = pk2(v[4][j], v[5][j]); o.w = pk2(v[6][j], v[7][j]);
        *(u32x4*)(dst + (size_t)j * K) = o; }
}
__device__ __forceinline__ void cvt_matrix(const float* W, int K, int N, bf16_t* WT, const float* rs, int w, int nw, int lane) {
    const int nitems = (K / 64) * (N / 32);
    for (int it = w; it < nitems; it += nw) cvt_item(W, K, N, WT, rs, it, lane);
}
__device__ __forceinline__ void cvt_wmq(const float* w_mq, const float* gain, bf16_t* o, int t, int nt) {
    const int nvec = DM * DM / 8;
    for (int i = t; i < nvec; i += nt) { const int k = i / (DM / 8); const float sc = gain[k] * C2_MEM;
        const f32x4 v0 = __builtin_nontemporal_load((const f32x4*)(w_mq + (size_t)i * 8)), v1 = __builtin_nontemporal_load((const f32x4*)(w_mq + (size_t)i * 8 + 4));
        u32x4 w; w.x = pk2(v0[0] * sc, v0[1] * sc); w.y = pk2(v0[2] * sc, v0[3] * sc); w.z = pk2(v1[0] * sc, v1[1] * sc); w.w = pk2(v1[2] * sc, v1[3] * sc);
        *(u32x4*)(o + (size_t)i * 8) = w; }
}
__device__ __forceinline__ void rms_row_to_bf16(const float* xrow, const float* gain, bf16_t* orow, int lane) {
    const f32x4* xr = (const f32x4*)xrow + lane; const f32x4* gr = (const f32x4*)gain + lane;
    f32x4 v[8]; float s = 0.f;
#pragma unroll
    for (int j = 0; j < 8; ++j) { v[j] = xr[64 * j]; s += (v[j][0] * v[j][0] + v[j][1] * v[j][1]) + (v[j][2] * v[j][2] + v[j][3] * v[j][3]); }
    const float r = __builtin_amdgcn_rsqf(wave_sum(s) * (1.f / DM) + EPS);
    u32x2* o8 = (u32x2*)orow + lane;
#pragma unroll
    for (int j = 0; j < 8; ++j) { const f32x4 gq = gr[64 * j]; u32x2 w; w.x = pk2(v[j][0] * r * gq[0], v[j][1] * r * gq[1]); w.y = pk2(v[j][2] * r * gq[2], v[j][3] * r * gq[3]); o8[64 * j] = w; }
}
__device__ __forceinline__ void cvt_p1(const Ctx& F, const Args& a, int w, int nw) {
    cvt_matrix(a.w_mo, DM, DM, (bf16_t*)(a.ws + WS_WMO), nullptr, w, nw, F.lane);
    cvt_wmq(a.w_mq, a.norm_mem_w, (bf16_t*)(a.ws + WS_WMQ), w * 64 + F.lane, nw * 64);
    cvt_matrix(a.w_out, DM, DM, (bf16_t*)(a.ws + WS_WOUT), nullptr, w, nw, F.lane);
}
__device__ __forceinline__ void cvt_up(const Ctx& F, const Args& a, int w, int nw) { cvt_matrix(a.w_up, DM, 2 * DFF, (bf16_t*)(a.ws + WS_WUP), a.norm_ffn_w, w, nw, F.lane); }
__device__ __forceinline__ void cvt_down(const Ctx& F, const Args& a, int w, int nw) { cvt_matrix(a.w_down, DFF, DM, (bf16_t*)(a.ws + WS_WDOWN), nullptr, w, nw, F.lane); }
__device__ __forceinline__ void p0_prologue(const Ctx& F, const Args& a, bool defer) {
    unsigned char* ws = a.ws;
    const int gw = F.vcu * NWAVES + F.wave, NGW = F.G * NWAVES;
    cvt_matrix(a.w_in, DM, DIN, (bf16_t*)(ws + WS_WIN), nullptr, gw, NGW, F.lane);
    for (int m = gw; m < MROWS; m += NGW) rms_row_to_bf16(a.x + (size_t)m * DM, a.norm_mix_w, (bf16_t*)(ws + WS_A1) + (size_t)m * DM, F.lane);
    for (int m = gw; m < BATCH * NMEM; m += NGW) rms_row_to_bf16(a.mem + (size_t)m * DM, a.mem_kv_norm_w, (bf16_t*)(ws + WS_MK) + (size_t)m * DM, F.lane);
    cvt_matrix(a.w_mkv, DM, 2 * DM, (bf16_t*)(ws + WS_WMKV), nullptr, gw, NGW, F.lane);
    if (!defer) { cvt_p1(F, a, gw, NGW); cvt_up(F, a, gw, NGW); cvt_down(F, a, gw, NGW); }
}

namespace att {
constexpr int KSLOT = 8192, VSLOT = 16384, L_K = 0, L_V = 2 * KSLOT, L_TB = L_V + 2 * VSLOT, L_WS = L_TB + 1024;
__device__ __forceinline__ void unit(const Ctx& F, int b, int h, int map, int qb, const bf16_t* Q, const bf16_t* Kt, const bf16_t* Vt, bf16_t* O, const float* rel_bias) {
    LAS unsigned char* lds = F.lds;
    const int lane = F.lane, wid = F.wave, r32 = lane & 31, hi = lane >> 5;
    LAS float* tb = (LAS float*)(lds + L_TB);
    LAS float* wsf = (LAS float*)(lds + L_WS) + wid * 64;
    __syncthreads();
    if (F.tid < 129) tb[F.tid] = rel_bias[(int)T5_BUCKET[F.tid] * 8 + h] * LOG2E;
    const long rowbase = (long)b * SEQ; const int qw0 = qb * 256 + wid * 32;
    const bf16_t* Kh = Kt + rowbase * 1024 + h * 128 + map * 64;
    const bf16_t* Vh = Vt + rowbase * 1024 + h * 128;
    bf16x8 qr[4];
    { const bf16_t* qp = Q + (rowbase + qw0 + r32) * 1024 + h * 128 + map * 64 + hi * 8;
#pragma unroll
      for (int d0 = 0; d0 < 4; ++d0) qr[d0] = *(const bf16x8*)(qp + d0 * 16); }
    const int NT = 4 * qb + 4, tmax = 4 * qb + (wid >> 1);
    const bf16_t* ksrc = Kh + (long)lane * 1024 + wid * 8;
    const int p0i = wid, p1i = wid + 8;
    const bf16_t* vsrc0 = Vh + (long)(16 * (p0i & 3) + (lane >> 2)) * 1024 + (p0i >> 2) * 32 + (lane & 3) * 8;
    const bf16_t* vsrc1 = Vh + (long)(16 * (p1i & 3) + (lane >> 2)) * 1024 + (p1i >> 2) * 32 + (lane & 3) * 8;
#define ATT_ISSUE(t, s) do { glds16(ksrc + (long)(t) * 64 * 1024, lds + L_K + (s) * KSLOT + wid * 1024); \
        glds16(vsrc0 + (long)(t) * 64 * 1024, lds + L_V + (s) * VSLOT + p0i * 1024); glds16(vsrc1 + (long)(t) * 64 * 1024, lds + L_V + (s) * VSLOT + p1i * 1024); } while (0)
    f32x16 o[4];
#pragma unroll
    for (int d = 0; d < 4; ++d) o[d] = (f32x16){};
    float mrun = -INFINITY, lrun = 0.f;
    const float tb_far = rel_bias[31 * 8 + h] * LOG2E;
    ATT_ISSUE(0, 0);
    for (int t = 0; t < NT; ++t) {
        VM_WAIT(); __syncthreads();
        if (t + 1 < NT) ATT_ISSUE(t + 1, (t + 1) & 1);
        if (t > tmax) continue;
        const int s = t & 1, k0 = t * 64;
        const bool far = (k0 + 63 + 128 <= qw0);
        f32x16 p0, p1;
        { const float ini = far ? tb_far : 0.f;
#pragma unroll
          for (int r = 0; r < 16; ++r) { p0[r] = ini; p1[r] = ini; } }
        const LAS unsigned char* kb = lds + L_K + s * KSLOT + hi * 1024 + r32 * 16;
#pragma unroll
        for (int d0 = 0; d0 < 4; ++d0) {
            const bf16x8 b0 = *(const LAS bf16x8*)(kb + d0 * 2048), b1 = *(const LAS bf16x8*)(kb + d0 * 2048 + 512);
            p0 = __builtin_amdgcn_mfma_f32_32x32x16_bf16(b0, qr[d0], p0, 0, 0, 0);
            p1 = __builtin_amdgcn_mfma_f32_32x32x16_bf16(b1, qr[d0], p1, 0, 0, 0);
        }
        if (!far) {
            const int base = qw0 + r32 - k0 - 4 * hi;
#pragma unroll
            for (int r = 0; r < 16; ++r) { const int rel0 = base - ((r & 3) + 8 * (r >> 2)), rel1 = rel0 - 32;
                const int i0 = rel0 < 0 ? 0 : (rel0 > 128 ? 128 : rel0), i1 = rel1 < 0 ? 0 : (rel1 > 128 ? 128 : rel1);
                p0[r] = rel0 < 0 ? -INFINITY : p0[r] + tb[i0]; p1[r] = rel1 < 0 ? -INFINITY : p1[r] + tb[i1]; }
        }
        float rm = fmaxf(p0[0], p1[0]);
#pragma unroll
        for (int r = 1; r < 16; ++r) rm = fmaxf(rm, fmaxf(p0[r], p1[r]));
        rm = fmaxf(rm, __shfl_xor(rm, 32));
        if (__any(rm > mrun + 8.0f)) {
            const float mn = fmaxf(mrun, rm), al = fexp2(mrun - mn);
            mrun = mn; lrun *= al;
            if (hi == 0) wsf[r32] = al;
            LDS_WAIT();
#pragma unroll
            for (int g4 = 0; g4 < 4; ++g4) { const f32x4 a4 = *(const LAS f32x4*)(wsf + 8 * g4 + 4 * hi);
#pragma unroll
                for (int d = 0; d < 4; ++d)
#pragma unroll
                    for (int j = 0; j < 4; ++j) o[d][4 * g4 + j] *= a4[j]; }
        }
        float sm = 0.f;
#pragma unroll
        for (int r = 0; r < 16; ++r) { p0[r] = fexp2(p0[r] - mrun); p1[r] = fexp2(p1[r] - mrun); sm += p0[r] + p1[r]; }
        lrun += sm;
        const bf16x8 pa0 = pack8(p0, 0), pa1 = pack8(p0, 8), pa2 = pack8(p1, 0), pa3 = pack8(p1, 8);
        const LAS unsigned char* vp = lds + L_V + s * VSLOT + ((lane >> 4) & 1) * 32 + (lane & 3) * 8 + (4 * hi + ((lane & 15) >> 2)) * 64;
#pragma unroll
        for (int d0 = 0; d0 < 4; ++d0) {
            const bf16x8 v0 = cat8(vtr(vp + d0 * 4096), vtr(vp + d0 * 4096 + 512));
            const bf16x8 v1 = cat8(vtr(vp + d0 * 4096 + 1024), vtr(vp + d0 * 4096 + 1024 + 512));
            const bf16x8 v2 = cat8(vtr(vp + d0 * 4096 + 2048), vtr(vp + d0 * 4096 + 2048 + 512));
            const bf16x8 v3 = cat8(vtr(vp + d0 * 4096 + 3072), vtr(vp + d0 * 4096 + 3072 + 512));
            o[d0] = __builtin_amdgcn_mfma_f32_32x32x16_bf16(pa0, v0, o[d0], 0, 0, 0);
            o[d0] = __builtin_amdgcn_mfma_f32_32x32x16_bf16(pa1, v1, o[d0], 0, 0, 0);
            o[d0] = __builtin_amdgcn_mfma_f32_32x32x16_bf16(pa2, v2, o[d0], 0, 0, 0);
            o[d0] = __builtin_amdgcn_mfma_f32_32x32x16_bf16(pa3, v3, o[d0], 0, 0, 0);
        }
    }
#undef ATT_ISSUE
    lrun += __shfl_xor(lrun, 32);
    if (hi == 0) wsf[32 + r32] = frcp(lrun);
    LDS_WAIT();
    bf16_t* Ow = O + (rowbase + qw0) * 1024 + h * 128 + r32;
#pragma unroll
    for (int g4 = 0; g4 < 4; ++g4) { const f32x4 a4 = *(const LAS f32x4*)(wsf + 32 + 8 * g4 + 4 * hi);
#pragma unroll
        for (int j = 0; j < 4; ++j) { const int row = 8 * g4 + 4 * hi + j;
#pragma unroll
            for (int d = 0; d < 4; ++d) Ow[(long)row * 1024 + d * 32] = (bf16_t)(pk2(o[d][4 * g4 + j] * a4[j], 0.f) & 0xffffu); } }
}
}

namespace hg {
__device__ __forceinline__ void prefix(const float* logf_base, int k, int j, float (&lf)[16], float (&G)[16], float& gl, float& g31, LAS float* part) {
    float run = 0.f;
#pragma unroll
    for (int i = 0; i < 16; ++i) { lf[i] = logf_base[(size_t)(16 * j + i) * 1024 + k]; run += lf[i]; G[i] = run; }
    part[j * 128 + k] = run;
    LDS_WAIT(); __syncthreads();
    const float p0 = part[k], p1 = part[128 + k], p2 = part[256 + k], p3 = part[384 + k];
    const float off = (j > 0 ? p0 : 0.f) + (j > 1 ? p1 : 0.f) + (j > 2 ? p2 : 0.f);
#pragma unroll
    for (int i = 0; i < 16; ++i) G[i] += off;
    gl = (p0 + p1) + (p2 + p3); g31 = p0 + p1;
}
__device__ __forceinline__ int sub_off(int s, int c, int nrg) { return (((c >> 5) * nrg + (s >> 4)) << 10) + (s & 15) * 64 + (c & 31) * 2; }
__device__ __forceinline__ int swz_off(int row, int c) { return row * 256 + ((((c >> 3) ^ (row & 15))) << 4) + (c & 7) * 2; }

constexpr int LA_KD = 0, LA_V = 16384, LA_PART = 32768;
__device__ __forceinline__ void pass_a(const Ctx& F, int unit, const float* logf, const bf16_t* hgi, bf16_t* Sloc, float* glast) {
    LAS unsigned char* lds = F.lds; const int lane = F.lane, wid = F.wave, hi = lane >> 5;
    const int bh = unit >> 6, c = unit & 63, b = bh >> 3, h = bh & 7; const size_t row0 = (size_t)b * SEQ + c * 64;
    __syncthreads();
#pragma unroll
    for (int q = 0; q < 2; ++q) { const int pi = wid + 8 * q; glds16(hgi + (row0 + 16 * (pi & 3) + (lane >> 2)) * 1024 + h * 128 + (pi >> 2) * 32 + (lane & 3) * 8, lds + LA_V + pi * 1024); }
    const int k = F.tid & 127, j = F.tid >> 7;
    float lf[16], G[16], gl, g31;
    prefix(logf + row0 * 1024 + h * 128, k, j, lf, G, gl, g31, (LAS float*)(lds + LA_PART));
    if (j == 0) glast[(size_t)unit * 128 + k] = gl;
#pragma unroll
    for (int i = 0; i < 16; ++i) { const int s = 16 * j + i; const float kd = (1.f - fexp(lf[i])) * fexp(gl - G[i]);
        *(LAS bf16_t*)(lds + LA_KD + sub_off(s, k, 4)) = (bf16_t)(pk2(kd, 0.f) & 0xffffu); }
    VM_WAIT(); LDS_WAIT(); __syncthreads();
    const int kb = wid >> 1;
    const int lo = ((lane >> 4) & 1) * 32 + (lane & 3) * 8 + (4 * hi + ((lane & 15) >> 2)) * 64;
    bf16x8 af[4];
#pragma unroll
    for (int ks = 0; ks < 4; ++ks) af[ks] = cat8(vtr(lds + LA_KD + (kb * 4 + ks) * 1024 + lo), vtr(lds + LA_KD + (kb * 4 + ks) * 1024 + lo + 512));
#pragma unroll
    for (int q = 0; q < 2; ++q) { const int vb = (wid & 1) * 2 + q; f32x16 acc = (f32x16){};
#pragma unroll
        for (int ks = 0; ks < 4; ++ks) { const bf16x8 bfr = cat8(vtr(lds + LA_V + (vb * 4 + ks) * 1024 + lo), vtr(lds + LA_V + (vb * 4 + ks) * 1024 + lo + 512));
            acc = __builtin_amdgcn_mfma_f32_32x32x16_bf16(af[ks], bfr, acc, 0, 0, 0); }
        bf16_t* o = Sloc + (size_t)unit * 16384 + vb * 32 + (lane & 31);
#pragma unroll
        for (int r = 0; r < 16; ++r) o[(size_t)(32 * kb + crow(r, hi)) * 128] = (bf16_t)(pk2(acc[r], 0.f) & 0xffffu); }
}
__device__ __forceinline__ void pass_b(const Ctx& F, const bf16_t* Sloc, const float* glast, bf16_t* Sin) {
    for (int gid = F.vcu * NTHREADS + F.tid; gid < 16 * 8192; gid += F.G * NTHREADS) {
        const int bh = gid >> 13, e2 = gid & 8191, k = e2 >> 6; const size_t eo = (size_t)e2 * 2;
        float s0 = 0.f, s1 = 0.f;
#pragma unroll 8
        for (int c = 0; c < 64; ++c) { const size_t un = (size_t)(bh * 64 + c);
            *(unsigned*)(Sin + un * 16384 + eo) = pk2(s0, s1);
            const float d = fexp(glast[un * 128 + k]); const unsigned w = *(const unsigned*)(Sloc + un * 16384 + eo);
            s0 = d * s0 + bflo(w); s1 = d * s1 + bfhi(w); }
    }
}
constexpr int LC_QG = 0, LC_QR = 16384, LC_KR = 32768, LC_V = 49152, LC_S = 65536, LC_PART = 98304, LC_RED = 100352;
__device__ __forceinline__ void pass_c(const Ctx& F, int unit, const float* logf, const bf16_t* hgq, const bf16_t* hgi, const bf16_t* hgg, const bf16_t* Sin, const float* nw, bf16_t* mix) {
    LAS unsigned char* lds = F.lds; const int lane = F.lane, wid = F.wave, hi = lane >> 5, l31 = lane & 31;
    const int bh = unit >> 6, c = unit & 63, b = bh >> 3, h = bh & 7; const size_t row0 = (size_t)b * SEQ + c * 64;
    __syncthreads();
#pragma unroll
    for (int q = 0; q < 2; ++q) { const int pi = wid + 8 * q; glds16(hgi + (row0 + 16 * (pi & 3) + (lane >> 2)) * 1024 + h * 128 + (pi >> 2) * 32 + (lane & 3) * 8, lds + LC_V + pi * 1024); }
#pragma unroll
    for (int q = 0; q < 4; ++q) { const int pi = wid + 8 * q;
        glds16(Sin + (size_t)unit * 16384 + (size_t)(16 * (pi & 7) + (lane >> 2)) * 128 + (pi >> 3) * 32 + (lane & 3) * 8, lds + LC_S + pi * 1024); }
    const int k = F.tid & 127, j = F.tid >> 7;
    { float lf[16], G[16], gl, g31;
      prefix(logf + row0 * 1024 + h * 128, k, j, lf, G, gl, g31, (LAS float*)(lds + LC_PART));
#pragma unroll
      for (int i = 0; i < 16; ++i) { const int t = 16 * j + i; const float q = bf2f(hgq[(row0 + t) * 1024 + h * 128 + k]);
          const float qg = q * fexp(G[i]), qrr = q * fexp(G[i] - g31), kr = (1.f - fexp(lf[i])) * fexp(g31 - G[i]);
          const int so = swz_off(t, k);
          *(LAS bf16_t*)(lds + LC_QG + so) = (bf16_t)(pk2(qg, 0.f) & 0xffffu);
          *(LAS bf16_t*)(lds + LC_QR + so) = (bf16_t)(pk2(qrr, 0.f) & 0xffffu);
          *(LAS bf16_t*)(lds + LC_KR + so) = (bf16_t)(pk2(kr, 0.f) & 0xffffu); } }
    VM_WAIT(); LDS_WAIT(); __syncthreads();
    const int tb = wid >> 2, vb = wid & 3;
    f32x16 sc0 = (f32x16){}, sc1 = (f32x16){};
    const int trow = 32 * tb + l31;
#pragma unroll
    for (int kk = 0; kk < 8; ++kk) { const int ch = 2 * kk + hi;
        const bf16x8 bq = *(const LAS bf16x8*)(lds + LC_QR + trow * 256 + ((ch ^ (trow & 15)) << 4));
        const bf16x8 a0 = *(const LAS bf16x8*)(lds + LC_KR + l31 * 256 + ((ch ^ (l31 & 15)) << 4));
        sc0 = __builtin_amdgcn_mfma_f32_32x32x16_bf16(a0, bq, sc0, 0, 0, 0);
        if (tb == 1) { const int sr = 32 + l31; const bf16x8 a1 = *(const LAS bf16x8*)(lds + LC_KR + sr * 256 + ((ch ^ (sr & 15)) << 4));
            sc1 = __builtin_amdgcn_mfma_f32_32x32x16_bf16(a1, bq, sc1, 0, 0, 0); } }
#pragma unroll
    for (int r = 0; r < 16; ++r) { const bool keep = crow(r, hi) <= l31; if (tb == 0) { if (!keep) sc0[r] = 0.f; } else { if (!keep) sc1[r] = 0.f; } }
    f32x16 o = (f32x16){};
    const int lo_p = ((lane >> 4) & 1) * 32 + (lane & 3) * 8 + (4 * hi + ((lane & 15) >> 2)) * 64;
    const int lo_n = ((lane >> 4) & 1) * 32 + (lane & 3) * 8 + (8 * hi + ((lane & 15) >> 2)) * 64;
    { const bf16x8 pa0 = pack8(sc0, 0), pa1 = pack8(sc0, 8);
      const bf16x8 v0 = cat8(vtr(lds + LC_V + (vb * 4 + 0) * 1024 + lo_p), vtr(lds + LC_V + (vb * 4 + 0) * 1024 + lo_p + 512));
      const bf16x8 v1 = cat8(vtr(lds + LC_V + (vb * 4 + 1) * 1024 + lo_p), vtr(lds + LC_V + (vb * 4 + 1) * 1024 + lo_p + 512));
      o = __builtin_amdgcn_mfma_f32_32x32x16_bf16(pa0, v0, o, 0, 0, 0); o = __builtin_amdgcn_mfma_f32_32x32x16_bf16(pa1, v1, o, 0, 0, 0);
      if (tb == 1) { const bf16x8 pb0 = pack8(sc1, 0), pb1 = pack8(sc1, 8);
          const bf16x8 v2 = cat8(vtr(lds + LC_V + (vb * 4 + 2) * 1024 + lo_p), vtr(lds + LC_V + (vb * 4 + 2) * 1024 + lo_p + 512));
          const bf16x8 v3 = cat8(vtr(lds + LC_V + (vb * 4 + 3) * 1024 + lo_p), vtr(lds + LC_V + (vb * 4 + 3) * 1024 + lo_p + 512));
          o = __builtin_amdgcn_mfma_f32_32x32x16_bf16(pb0, v2, o, 0, 0, 0); o = __builtin_amdgcn_mfma_f32_32x32x16_bf16(pb1, v3, o, 0, 0, 0); } }
#pragma unroll
    for (int kk = 0; kk < 8; ++kk) { const int ch = 2 * kk + hi;
        const bf16x8 aq = *(const LAS bf16x8*)(lds + LC_QG + trow * 256 + ((ch ^ (trow & 15)) << 4));
        const bf16x8 bs = cat8(vtr(lds + LC_S + (vb * 8 + kk) * 1024 + lo_n), vtr(lds + LC_S + (vb * 8 + kk) * 1024 + lo_n + 256));
        o = __builtin_amdgcn_mfma_f32_32x32x16_bf16(aq, bs, o, 0, 0, 0); }
    LAS float* red = (LAS float*)(lds + LC_RED);
#pragma unroll
    for (int r = 0; r < 16; ++r) { float s = o[r] * o[r];
        s += __shfl_xor(s, 1); s += __shfl_xor(s, 2); s += __shfl_xor(s, 4); s += __shfl_xor(s, 8); s += __shfl_xor(s, 16);
        if (l31 == 0) red[(32 * tb + crow(r, hi)) * 4 + vb] = s; }
    LDS_WAIT(); __syncthreads();
    const int v = 32 * vb + l31; const float nwv = nw[v];
#pragma unroll
    for (int r = 0; r < 16; ++r) { const int t = 32 * tb + crow(r, hi); const f32x4 p = *(const LAS f32x4*)(red + t * 4);
        const float ri = __builtin_amdgcn_rsqf(((p[0] + p[1]) + (p[2] + p[3])) * (1.f / 128.f) + EPS);
        const float gv = bf2f(hgg[(row0 + t) * 1024 + h * 128 + v]);
        const float out = o[r] * ri * nwv * gv * frcp(1.f + fexp(-gv));
        mix[(row0 + t) * DM + 1024 + h * 128 + v] = (bf16_t)(pk2(out, 0.f) & 0xffffu); }
}
}

__device__ __forceinline__ void da_combine(const Ctx& F, const Args& a, const bf16_t* O, bf16_t* mix) {
    const int lane = F.lane;
    float d1 = a.lam_q1[lane] * a.lam_k1[lane], d2 = a.lam_q2[lane] * a.lam_k2[lane];
    const float lam = fexp(wave_sum(d1)) - fexp(wave_sum(d2)) + 0.2f;
    const int gw = F.vcu * NWAVES + F.wave, NGW = F.G * NWAVES;
    float w[16];
#pragma unroll
    for (int i = 0; i < 16; ++i) w[i] = a.da_subln_w[(lane & 7) * 16 + i] * 0.8f;
    for (int m = gw; m < MROWS; m += NGW) {
        const u32x4 a0 = *(const u32x4*)(O + (size_t)m * 1024 + lane * 16), a1 = *(const u32x4*)(O + (size_t)m * 1024 + lane * 16 + 8);
        const u32x4 b0 = *(const u32x4*)(O + SEG + (size_t)m * 1024 + lane * 16), b1 = *(const u32x4*)(O + SEG + (size_t)m * 1024 + lane * 16 + 8);
        float v[16]; float ss = 0.f;
#pragma unroll
        for (int i = 0; i < 4; ++i) { v[2 * i] = bflo(a0[i]) - lam * bflo(b0[i]); v[2 * i + 1] = bfhi(a0[i]) - lam * bfhi(b0[i]);
            v[8 + 2 * i] = bflo(a1[i]) - lam * bflo(b1[i]); v[8 + 2 * i + 1] = bfhi(a1[i]) - lam * bfhi(b1[i]); }
#pragma unroll
        for (int i = 0; i < 16; ++i) ss += v[i] * v[i];
        ss += __shfl_xor(ss, 1); ss += __shfl_xor(ss, 2); ss += __shfl_xor(ss, 4);
        const float r = __builtin_amdgcn_rsqf(ss * (1.f / 128.f) + EPS);
        u32x4 o0, o1;
#pragma unroll
        for (int i = 0; i < 4; ++i) { o0[i] = pk2(v[2 * i] * r * w[2 * i], v[2 * i + 1] * r * w[2 * i + 1]); o1[i] = pk2(v[8 + 2 * i] * r * w[8 + 2 * i], v[8 + 2 * i + 1] * r * w[8 + 2 * i + 1]); }
        *(u32x4*)(mix + (size_t)m * DM + lane * 16) = o0; *(u32x4*)(mix + (size_t)m * DM + lane * 16 + 8) = o1;
    }
}

__device__ __forceinline__ void conv_fixup(const Ctx& F, const Args& a, const bf16_t* Y4, bf16_t* Gm) {
    const int total = 32 * 2 * DFF;
    for (int i = F.vcu * NTHREADS + F.tid; i < total; i += F.G * NTHREADS) {
        const int c = i % DFF, rr = (i / DFF) & 1, pm = i / (2 * DFF);
        if ((pm & 15) == 0) continue;
        float u2[2];
#pragma unroll
        for (int bj = 0; bj < 2; ++bj) { const int cc = bj * DFF + c;
            const float ym2 = bf2f(Y4[((size_t)(pm - 1) * 4 + 2) * (2 * DFF) + cc]), ym1 = bf2f(Y4[((size_t)(pm - 1) * 4 + 3) * (2 * DFF) + cc]);
            const float y0 = bf2f(Y4[((size_t)pm * 4 + 0) * (2 * DFF) + cc]), y1 = bf2f(Y4[((size_t)pm * 4 + 1) * (2 * DFF) + cc]);
            const float w0 = a.conv_w[cc], w1 = a.conv_w[2 * DFF + cc], w2 = a.conv_w[4 * DFF + cc], bb = a.conv_b[cc];
            u2[bj] = rr == 0 ? bb + w0 * ym2 + w1 * ym1 + w2 * y0 : bb + w0 * ym1 + w1 * y0 + w2 * y1; }
        const float gv = u2[0] * frcp(1.f + fexp(-u2[0])) * u2[1];
        Gm[(size_t)(pm * 256 + rr) * DFF + c] = (bf16_t)(pk2(gv, 0.f) & 0xffffu);
    }
}
__device__ __forceinline__ void final_norm(const Ctx& F, const Args& a, const float* rss, const float* xin, float* out) {
    const int gw = F.vcu * NWAVES + F.wave, NGW = F.G * NWAVES, lane = F.lane;
    for (int m = gw; m < MROWS; m += NGW) {
        const float r = pg8::row_rinv(rss, m);
        const f32x4* xr = (const f32x4*)(xin + (size_t)m * DM) + lane; f32x4* orow = (f32x4*)(out + (size_t)m * DM) + lane; const f32x4* gr = (const f32x4*)a.final_norm_w + lane;
#pragma unroll
        for (int j = 0; j < 8; ++j) { const f32x4 v = xr[64 * j], gq = gr[64 * j]; orow[64 * j] = v * gq * r; }
    }
}

constexpr int N_PHASES = 12;
template <int PM> __global__ void __launch_bounds__(NTHREADS, 2) hymba_fwd(Args args) {
    extern __shared__ __attribute__((aligned(16))) unsigned char lds_raw[];
    Ctx F0; F0.lds = (LAS unsigned char*)lds_raw;
    F0.tid = threadIdx.x; F0.lane = F0.tid & 63; F0.wave = __builtin_amdgcn_readfirstlane(F0.tid >> 6);
    F0.G = gridDim.x; { const int bx = blockIdx.x; F0.vcu = (F0.G % 8 == 0) ? (bx % 8) * (F0.G / 8) + bx / 8 : bx; }
    unsigned char* ws = args.ws;
    volatile LAS unsigned* MISC = (volatile LAS unsigned*)(F0.lds + MISC_OFF);
    if (F0.tid < 32) MISC[F0.tid] = 0u;
    __syncthreads();
    XcdBarrier bar; bar.bar = (unsigned*)(ws + WS_CTL) + CW_BAR; bar.x = 0; bar.st = nullptr;
    const int lo = args.ph_lo, hi = args.ph_hi;
    if (hi - lo > 1) bar = xcd_barrier_post((unsigned*)(ws + WS_CTL) + CW_BAR, MISC + 8);
#define IN(k) ((((PM) >> (k)) & 1) && lo <= (k) && (k) < hi)
#define SEAM(k) do { if (IN(k) && IN((k) + 1)) xcd_barrier(bar); } while (0)
#ifndef DUP_MASK
#define DUP_MASK 224
#endif
#define NREP(k) ((((DUP_MASK) >> (k)) & 1) ? 2 : 1)
#define REP(k) for (int rep_ = 0; rep_ < NREP(k); ++rep_, (rep_ < NREP(k) ? xcd_barrier(bar) : (void)0))
    const int bx = (int)blockIdx.x, G = F0.G;
    bf16_t* const A1 = (bf16_t*)(ws + WS_A1); bf16_t* const A2 = (bf16_t*)(ws + WS_A2); bf16_t* const A3 = (bf16_t*)(ws + WS_A3); float* const LOGF = (float*)(ws + WS_A4);
    bf16_t* const SLOC = (bf16_t*)((unsigned char*)args.out + OUT_SLOC); bf16_t* const OB = (bf16_t*)((unsigned char*)args.out + OUT_O);
    float* const GLAST = (float*)(ws + WS_GLAST);
    float* const X1 = (float*)(ws + WS_A3);
    float* const X3 = (float*)(ws + WS_WIN);

    const bool defer = (G == 256);
    REP(0) if (IN(0)) { const Ctx F = fresh(F0); p0_prologue(F, args, defer); }
    SEAM(0);
    REP(1) if (IN(1)) { const Ctx F = fresh(F0);
        { pg8::Gemm g{A1, (const bf16_t*)(ws + WS_WIN), DM, DM, DM, 0, 0, 0, 0, 256L * DM, 128L * DM, 0}; pg8::Order S; S.init(MROWS / 256, DIN / 256, 1, G, bx);
          pg8::EpiInProj E{A2, A3, LOGF, args.hg_lb_raw};
          pg8::gemm_phase<pg8::EpiInProj, true>(F.lds, g, S, E); }
        { pg8::Gemm g{(const bf16_t*)(ws + WS_MK), (const bf16_t*)(ws + WS_WMKV), DM, DM, DM, 0, 0, 0, 0, 256L * DM, 128L * DM, 0}; pg8::Order S; S.init(2, 16, 1, G, (bx + G / 2) % G);
          pg8::EpiBf16 E{(bf16_t*)(ws + WS_KVMEM), 2 * DM, 0, 0};
          pg8::gemm_phase<pg8::EpiBf16, true>(F.lds, g, S, E); }
        if (defer && bx >= 160) cvt_p1(F, args, (bx - 160) * NWAVES + F.wave, 96 * NWAVES);
    }
    SEAM(1);
    REP(2) if (IN(2)) { const Ctx F = fresh(F0);
        { const int bhm = F.vcu >> 3, s = F.vcu & 7;
          if (G == 256) { const int b = bhm >> 4, h = (bhm >> 1) & 7, map = bhm & 1;
              att::unit(F, b, h, map, 15 - s, A2, A2 + SEG, A2 + 2 * SEG, OB + (size_t)map * SEG, args.rel_bias);
              att::unit(F, b, h, map, s, A2, A2 + SEG, A2 + 2 * SEG, OB + (size_t)map * SEG, args.rel_bias);
          } else { for (int un = F.vcu; un < 512; un += G) { const int bhm2 = un >> 4, qb = un & 15; att::unit(F, bhm2 >> 4, (bhm2 >> 1) & 7, bhm2 & 1, qb, A2, A2 + SEG, A2 + 2 * SEG, OB + (size_t)(bhm2 & 1) * SEG, args.rel_bias); } } }
        for (int un = F.vcu; un < 1024; un += G) hg::pass_a(F, un, LOGF, A3 + SEG, SLOC, GLAST);
        VM_WAIT(); __syncthreads();
        { pg8::Gemm g{(const bf16_t*)(ws + WS_KVMEM), (const bf16_t*)(ws + WS_WMQ), 2 * DM, DM, 512, 256L * 4096, 512, 0, 512, 256L * DM, 128L * DM, 0}; pg8::Order S; S.init(1, 8, 8, G, bx);
          pg8::EpiBf16 E{(bf16_t*)(ws + WS_WKT), DM, 1024L * DM, 256L * DM};
          pg8::gemm_phase<pg8::EpiBf16, true>(F.lds, g, S, E); }
        { pg8::Gemm g{(const bf16_t*)(ws + WS_WMO), (const bf16_t*)(ws + WS_KVMEM) + DM, DM, 2 * DM, 512, 0, 512, 256L * 4096, 512, 256L * 4096, 128L * 4096, 0}; pg8::Order S; S.init(8, 1, 8, G, (bx + 64) % G);
          pg8::EpiBf16 E{(bf16_t*)(ws + WS_VWT), 1024, (long)DM * 1024, 256};
          pg8::gemm_phase<pg8::EpiBf16, true>(F.lds, g, S, E); }
    }
    SEAM(2);
    REP(3) if (IN(3)) { const Ctx F = fresh(F0); hg::pass_b(F, SLOC, GLAST, A1); }
    SEAM(3);
    REP(4) if (IN(4)) { const Ctx F = fresh(F0);
        for (int un = F.vcu; un < 1024; un += G) hg::pass_c(F, un, LOGF, A3, A3 + SEG, A3 + 2 * SEG, A1, args.hg_norm_w, A2);
        da_combine(F, args, OB, A2);
    }
    SEAM(4);
    REP(5) if (IN(5)) { const Ctx F = fresh(F0);
        pg8::Gemm g{A2, (const bf16_t*)(ws + WS_WOUT), DM, DM, DM, 0, 0, 0, 0, 256L * DM, 128L * DM, 0}; pg8::Order S; S.init(MROWS / 256, DM / 256, 1, G, bx);
        pg8::EpiResid<true> E{args.x, X1, A1, (float*)(ws + WS_RSS1)};
        pg8::gemm_phase<pg8::EpiResid<true>, false>(F.lds, g, S, E);
    }
    SEAM(5);
    REP(6) if (IN(6)) { const Ctx F = fresh(F0);
        pg8::Gemm g{A1, (const bf16_t*)(ws + WS_WKT), DM, DM, DM, 0, 0, 0, 0, 256L * DM, 128L * DM, 1024L * DM}; pg8::Order S; S.init(MROWS / 256, 4, 1, G, bx);
        pg8::EpiSoftmax E{(const float*)(ws + WS_RSS1), A2};
        pg8::gemm_phase<pg8::EpiSoftmax, false>(F.lds, g, S, E);
        if (defer && bx >= 128) cvt_up(F, args, (bx - 128) * NWAVES + F.wave, 128 * NWAVES);
    }
    SEAM(6);
    REP(7) if (IN(7)) { const Ctx F = fresh(F0);
        pg8::Gemm g{A2, (const bf16_t*)(ws + WS_VWT), 1024, 1024, 1024, 0, 0, 0, 0, 256L * 1024, 128L * 1024, (long)DM * 1024}; pg8::Order S; S.init(MROWS / 256, DM / 256, 1, G, bx);
        pg8::EpiResid<true> E{X1, args.out, A1, (float*)(ws + WS_RSS2)};
        pg8::gemm_phase<pg8::EpiResid<true>, false>(F.lds, g, S, E);
    }
    SEAM(7);
    REP(8) if (IN(8)) { const Ctx F = fresh(F0);
        pg8::Gemm g{A1, (const bf16_t*)(ws + WS_WUP), DM, DM, DM, 0, 0, 0, 0, 128L * DM, (long)DFF * DM, 0}; pg8::Order S; S.init(MROWS / 256, DFF / 128, 1, G, bx);
        pg8::EpiUp E{(const float*)(ws + WS_RSS2), args.conv_w, args.conv_b, (bf16_t*)(ws + WS_G), (bf16_t*)(ws + WS_Y4)};
        pg8::gemm_phase<pg8::EpiUp, true>(F.lds, g, S, E);
        if (defer && bx >= 128) cvt_down(F, args, (bx - 128) * NWAVES + F.wave, 128 * NWAVES);
    }
    SEAM(8);
    REP(9) if (IN(9)) { const Ctx F = fresh(F0); conv_fixup(F, args, (const bf16_t*)(ws + WS_Y4), (bf16_t*)(ws + WS_G)); }
    SEAM(9);
    REP(10) if (IN(10)) { const Ctx F = fresh(F0);
        pg8::Gemm g{(const bf16_t*)(ws + WS_G), (const bf16_t*)(ws + WS_WDOWN), DFF, DFF, DFF, 0, 0, 0, 0, 256L * DFF, 128L * DFF, 0}; pg8::Order S; S.init(MROWS / 256, DM / 256, 1, G, bx);
        pg8::EpiResid<false> E{args.out, X3, nullptr, (float*)(ws + WS_RSS3)};
        pg8::gemm_phase<pg8::EpiResid<false>, false>(F.lds, g, S, E);
    }
    SEAM(10);
    REP(11) if (IN(11)) { const Ctx F = fresh(F0); final_norm(F, args, (const float*)(ws + WS_RSS3), X3, args.out); }
#undef IN
#undef SEAM
}

typedef void (*kern_t)(Args);
#ifndef PHASE_MASK
#define PHASE_MASK 0xFFF
#endif
static kern_t phase_kernel(int p) {
    switch (p) {
        case 0: return hymba_fwd<1 << 0>; case 1: return hymba_fwd<1 << 1>; case 2: return hymba_fwd<1 << 2>; case 3: return hymba_fwd<1 << 3>;
        case 4: return hymba_fwd<1 << 4>; case 5: return hymba_fwd<1 << 5>; case 6: return hymba_fwd<1 << 6>; case 7: return hymba_fwd<1 << 7>;
        case 8: return hymba_fwd<1 << 8>; case 9: return hymba_fwd<1 << 9>; case 10: return hymba_fwd<1 << 10>; default: return hymba_fwd<1 << 11>;
    }
}
extern "C" void kernel_launch(void* const* d_in, const int* in_sizes, int n_in, void* d_out, int out_size, void* d_ws, size_t ws_size, hipStream_t stream) {
    static int grid = 0;
    if (grid == 0) {
        if (n_in != 24 || in_sizes[0] != MROWS * DM || out_size != MROWS * DM || ws_size < WS_END) {
            fprintf(stderr, "kernel_launch: unexpected problem (n_in %d, in0 %d, out %d, ws %zu)\n", n_in, n_in > 0 ? in_sizes[0] : -1, out_size, ws_size); grid = -1; return; }
        int dev = 0, cus = 0, per_cu = 0;
        if (hipGetDevice(&dev) != hipSuccess || hipDeviceGetAttribute(&cus, hipDeviceAttributeMultiprocessorCount, dev) != hipSuccess) { grid = -1; return; }
        bool ok = true;
        if (MK_N_LAUNCHES == 1) {
            ok = hipFuncSetAttribute((const void*)hymba_fwd<PHASE_MASK>, hipFuncAttributeMaxDynamicSharedMemorySize, LDS_BYTES) == hipSuccess;
            if (hipOccupancyMaxActiveBlocksPerMultiprocessor(&per_cu, (const void*)hymba_fwd<PHASE_MASK>, NTHREADS, LDS_BYTES) != hipSuccess || per_cu < 1) { fprintf(stderr, "kernel_launch: occupancy query says %d\n", per_cu); }
        } else {
            for (int p = 0; p < N_PHASES; ++p) ok = ok && hipFuncSetAttribute((const void*)phase_kernel(p), hipFuncAttributeMaxDynamicSharedMemorySize, LDS_BYTES) == hipSuccess;
        }
        (void)hipGetLastError();
        if (!ok) { fprintf(stderr, "kernel_launch: hipFuncSetAttribute failed\n"); grid = -1; return; }
        grid = cus;
        if (grid != 256) fprintf(stderr, "kernel_launch: %d CUs; this build assumes 256\n", grid);
    }
    if (grid < 0) return;
    (void)hipMemsetAsync((char*)d_ws + WS_CTL, 0, CTL_ZERO_BYTES, stream);
    Args a{};
    const float** ap = (const float**)&a;
    for (int i = 0; i < 24; ++i) ap[i] = (const float*)d_in[i];
    a.out = (float*)d_out; a.ws = (unsigned char*)d_ws;
    if (MK_N_LAUNCHES == 1) { a.ph_lo = 0; a.ph_hi = N_PHASES; hipLaunchKernelGGL(hymba_fwd<PHASE_MASK>, dim3(grid), dim3(NTHREADS), LDS_BYTES, stream, a); }
    else { for (int p = 0; p < N_PHASES; ++p) { a.ph_lo = p; a.ph_hi = p + 1; hipLaunchKernelGGL(phase_kernel(p), dim3(grid), dim3(NTHREADS), LDS_BYTES, stream, a); } }
}
```

```cpp
#include <hip/hip_runtime.h>
#include <cstdint>
#include <cstdio>

#ifndef MK_N_LAUNCHES
#define MK_N_LAUNCHES 1
#endif

#define LAS __attribute__((address_space(3)))
#define GAS __attribute__((address_space(1)))
typedef unsigned short bf16_t;
typedef short bf16x8 __attribute__((ext_vector_type(8)));
typedef short s16x4 __attribute__((ext_vector_type(4)));
typedef float f32x2 __attribute__((ext_vector_type(2)));
typedef float f32x4 __attribute__((ext_vector_type(4)));
typedef float f32x16 __attribute__((ext_vector_type(16)));
typedef unsigned u32x2 __attribute__((ext_vector_type(2)));
typedef unsigned u32x4 __attribute__((ext_vector_type(4)));
typedef GAS unsigned gu32;

constexpr int BATCH = 2, SEQ = 4096, DM = 2048, MROWS = BATCH * SEQ;
constexpr int DIN = 7168, DFF = 5632, NMEM = 256;
constexpr float EPS = 1e-6f;
constexpr float LOG2E = 1.4426950408889634f;
constexpr float C2_DA = 0.125f * LOG2E;
constexpr float C2_MEM = 0.04419417382415922f * LOG2E;
constexpr int NWAVES = 8, NTHREADS = 512;

constexpr size_t MiB = 1u << 20;
constexpr size_t WS_CTL = 0, CTL_ZERO_BYTES = 1 * MiB;
constexpr size_t WS_RSS1 = 1 * MiB, WS_RSS2 = WS_RSS1 + 256 * 1024, WS_RSS3 = WS_RSS2 + 256 * 1024;
constexpr size_t WS_GLAST = 2 * MiB;
constexpr size_t WS_WIN = 4 * MiB, WS_WOUT = 32 * MiB, WS_WMQ = 40 * MiB, WS_WMKV = 48 * MiB, WS_WMO = 64 * MiB, WS_WUP = 72 * MiB, WS_WDOWN = 116 * MiB;
constexpr size_t WS_KVMEM = 138 * MiB, WS_WKT = 142 * MiB, WS_VWT = 150 * MiB, WS_MK = 158 * MiB;
constexpr size_t WS_A1 = 160 * MiB;
constexpr size_t WS_A2 = 192 * MiB;
constexpr size_t WS_A3 = 240 * MiB;
constexpr size_t WS_A4 = 288 * MiB;
constexpr size_t WS_G = 192 * MiB;
constexpr size_t WS_Y4 = 280 * MiB;
constexpr size_t WS_END = 320 * MiB;
constexpr size_t OUT_SLOC = 0, OUT_O = 32 * MiB;
constexpr size_t SEG = (size_t)MROWS * 1024;

constexpr int CW_BAR = 4096;

constexpr int RING_BYTES = 131072, SPARE_OFF = RING_BYTES, SPARE_BYTES = 12288, MISC_OFF = SPARE_OFF + SPARE_BYTES;
constexpr int LDS_BYTES = 147456;

#define RLX_AGENT __ATOMIC_RELAXED, __HIP_MEMORY_SCOPE_AGENT
#define LDS_WAIT() asm volatile("s_waitcnt lgkmcnt(0)" ::: "memory")
#define VM_WAIT() asm volatile("s_waitcnt vmcnt(0)" ::: "memory")
typedef __bf16 bf16x2_t __attribute__((ext_vector_type(2)));
__device__ __forceinline__ unsigned pk2(float lo, float hi) { f32x2 v = {lo, hi}; bf16x2_t b = __builtin_convertvector(v, bf16x2_t); return __builtin_bit_cast(unsigned, b); }
__device__ __forceinline__ float bf2f(unsigned short b) { return __builtin_bit_cast(float, (unsigned)b << 16); }
__device__ __forceinline__ float bflo(unsigned w) { return __builtin_bit_cast(float, w << 16); }
__device__ __forceinline__ float bfhi(unsigned w) { return __builtin_bit_cast(float, w & 0xffff0000u); }
__device__ __forceinline__ float fexp2(float x) { return __builtin_amdgcn_exp2f(x); }
__device__ __forceinline__ float fexp(float x) { return __builtin_amdgcn_exp2f(x * LOG2E); }
__device__ __forceinline__ float frcp(float x) { return __builtin_amdgcn_rcpf(x); }
__device__ __forceinline__ float wave_sum(float v) {
#pragma unroll
    for (int o = 1; o < 64; o <<= 1) v += __shfl_xor(v, o);
    return v;
}
__device__ __forceinline__ int crow(int r, int hi) { return (r & 3) + 8 * (r >> 2) + 4 * hi; }
__device__ __forceinline__ s16x4 vtr(const LAS unsigned char* p) {
    typedef short v4i16_t __attribute__((ext_vector_type(4)));
    return __builtin_bit_cast(s16x4, __builtin_amdgcn_ds_read_tr16_b64_v4i16((LAS v4i16_t*)p));
}
__device__ __forceinline__ bf16x8 cat8(s16x4 a, s16x4 b) { return (bf16x8){a[0], a[1], a[2], a[3], b[0], b[1], b[2], b[3]}; }
__device__ __forceinline__ bf16x8 pack8(const f32x16& p, int b) {
    u32x4 w = {pk2(p[b], p[b + 1]), pk2(p[b + 2], p[b + 3]), pk2(p[b + 4], p[b + 5]), pk2(p[b + 6], p[b + 7])};
    return __builtin_bit_cast(bf16x8, w);
}
__device__ __forceinline__ void glds16(const void* g, LAS unsigned char* l) {
    __builtin_amdgcn_global_load_lds((const GAS unsigned*)g, (LAS unsigned*)l, 16, 0, 0);
}

__device__ const unsigned char T5_BUCKET[132] = {0, 1, 2, 3, 4, 5, 6, 7, 8, 9, 10, 11, 12, 13, 14, 15, 16, 16, 16, 17, 17, 18, 18, 18, 19, 19, 19, 20, 20, 20, 20, 21, 21, 21, 21, 22, 22, 22, 22, 22, 23, 23, 23, 23, 23, 23, 24, 24, 24, 24, 24, 24, 25, 25, 25, 25, 25, 25, 25, 26, 26, 26, 26, 26, 26, 26, 26, 27, 27, 27, 27, 27, 27, 27, 27, 27, 27, 28, 28, 28, 28, 28, 28, 28, 28, 28, 28, 29, 29, 29, 29, 29, 29, 29, 29, 29, 29, 29, 29, 30, 30, 30, 30, 30, 30, 30, 30, 30, 30, 30, 30, 30, 30, 31, 31, 31, 31, 31, 31, 31, 31, 31, 31, 31, 31, 31, 31, 31, 31, 31, 31, 31};

namespace pg8 {
constexpr int BM = 256, BK = 64, HALF = 128, HTB = HALF * BK * 2, STAGE_BYTES = 8 * HTB, NXCD = 8, WGM = 8;
__host__ __device__ __forceinline__ int lds_byte(int r, int c) { const int st = (r >> 4) * 2 + (c >> 5), rr = r & 15, cc = c & 31, ob = rr * 64 + cc * 2; return st * 1024 + (ob ^ (((ob >> 9) & 1) << 5)); }
__host__ __device__ __forceinline__ void stage_rc(int b, int& R, int& C) { const int st = b / 1024, sb = b % 1024, swz = sb ^ (((sb >> 9) & 1) << 5); R = (st >> 1) * 16 + swz / 64; C = (st & 1) * 32 + (swz % 64) / 2; }
__host__ __device__ __forceinline__ int perm32(int rho) { const int n = rho >> 4, i = rho & 15; return 8 * (i >> 2) + 4 * n + (i & 3); }

struct Unit { int pm, pn, zb, zh; };
struct Gemm { const bf16_t* A; const bf16_t* Bt; int lda, ldb, K; long a_zb, a_zh, b_zb, b_zh, b_tile, b_half, b_batch; };
struct Order {
    int nM, nN, total, G, c;
    __device__ void init(int nM_, int nN_, int nZ_, int G_, int c_) { nM = nM_; nN = nN_; total = nM_ * nN_ * nZ_; G = G_; c = c_; }
    __device__ __forceinline__ bool next(int i, Unit& u) const {
        const long L = (long)i * G + c; if (L >= total) return false;
        int wgid = (int)L; { const int q = total / NXCD, r = total % NXCD, xcd = wgid % NXCD, off = wgid / NXCD; wgid = (xcd < r ? xcd * (q + 1) : r * (q + 1) + (xcd - r) * q) + off; }
        const int per = nM * nN, z = wgid / per, w = wgid % per;
        const int nig = WGM * nN, gid = w / nig, fm = gid * WGM, gsz = (nM - fm) < WGM ? (nM - fm) : WGM;
        u.pm = fm + ((w % nig) % gsz); u.pn = (w % nig) / gsz; u.zb = z >> 2; u.zh = z & 3; return true;
    }
};
__device__ __forceinline__ const char* a_ptr(const Gemm& g, const Unit& u) { return (const char*)(g.A + u.zb * g.a_zb + u.zh * g.a_zh + (long)u.pm * BM * g.lda); }
__device__ __forceinline__ const char* b_ptr(const Gemm& g, const Unit& u) { return (const char*)(g.Bt + u.zb * g.b_zb + u.zh * g.b_zh + (long)u.pn * g.b_tile + (long)(u.pm >> 4) * g.b_batch); }

template <class Epi, bool ALIGN_EPI>
__device__ __forceinline__ void gemm_phase(LAS unsigned char* lds, const Gemm& g, const Order& S, const Epi& E) {
    int tid_ = threadIdx.x; asm volatile("" : "+v"(tid_));
    const int tid = tid_, wid = __builtin_amdgcn_readfirstlane(tid >> 6), lane = tid & 63, wr = wid >> 2, wc = wid & 3, fr = lane & 15, fq = lane >> 4;
    const int K = g.K, nt = K / BK;
    unsigned voffA[2], voffB[2];
#pragma unroll
    for (int i = 0; i < 2; ++i) { int R, C; stage_rc(tid * 16 + i * 8192, R, C); const int Rb = Epi::PERM ? ((R & ~31) + perm32(R & 31)) : R;
        voffA[i] = (unsigned)(R * g.lda + C) * 2u; voffB[i] = (unsigned)(Rb * g.ldb + C) * 2u; }
    const size_t kstep = (size_t)(BK * 2);
    const size_t hstepA = (size_t)HALF * g.lda * 2, hstepB = (size_t)g.b_half * 2;
    const unsigned ldsw = (unsigned)wid * 1024u;
    const int aoff = lds_byte(wr * 64 + fr, fq * 8), boff = lds_byte(wc * 32 + fr, fq * 8);
#define PG8_SA(b, h) (((b) * 2 + (h)) * HTB)
#define PG8_SB(b, h) ((4 + (b) * 2 + (h)) * HTB)
#define PG8_STAGE(bufoff, gbase, voff) do { _Pragma("unroll") for (int _i = 0; _i < 2; ++_i) \
        __builtin_amdgcn_global_load_lds((const GAS unsigned*)((const char*)(gbase) + (voff)[_i]), (LAS unsigned*)(lds + (bufoff) + ldsw + _i * 8192), 16, 0, 0); } while (0)
#define PG8_LDA(dst, b, h) do { _Pragma("unroll") for (int m = 0; m < 4; ++m) _Pragma("unroll") for (int k = 0; k < 2; ++k) dst[m][k] = *(const LAS bf16x8*)(lds + PG8_SA(b, h) + aoff + m * 2048 + k * 1024); } while (0)
#define PG8_LDB(dst, b, h) do { _Pragma("unroll") for (int n = 0; n < 2; ++n) _Pragma("unroll") for (int k = 0; k < 2; ++k) dst[n][k] = *(const LAS bf16x8*)(lds + PG8_SB(b, h) + boff + n * 2048 + k * 1024); } while (0)
#define PG8_MMA(ai, bj, At, Bt) do { __builtin_amdgcn_s_setprio(1); _Pragma("unroll") for (int m = 0; m < 4; ++m) _Pragma("unroll") for (int n = 0; n < 2; ++n) _Pragma("unroll") for (int k = 0; k < 2; ++k) \
        acc[ai][bj][m][n] = __builtin_amdgcn_mfma_f32_16x16x32_bf16(Bt[n][k], At[m][k], acc[ai][bj][m][n], 0, 0, 0); __builtin_amdgcn_s_setprio(0); } while (0)
#define PG8_WAIT_V(n) asm volatile("s_waitcnt vmcnt(" #n ")" ::: "memory")
#define PG8_WAIT_L(n) asm volatile("s_waitcnt lgkmcnt(" #n ")" ::: "memory")
#define PG8_BAR __builtin_amdgcn_s_barrier()
#define PG8_SCHED __builtin_amdgcn_sched_barrier(0)
    Unit cur, nxt; int ui = 0;
    if (!S.next(0, cur)) return;
    f32x4 acc[2][2][4][2];
#pragma unroll
    for (int a = 0; a < 2; ++a)
#pragma unroll
        for (int b = 0; b < 2; ++b)
#pragma unroll
            for (int m = 0; m < 4; ++m)
#pragma unroll
                for (int n = 0; n < 2; ++n) acc[a][b][m][n] = (f32x4){0.f, 0.f, 0.f, 0.f};
    bf16x8 At[4][2], B0[2][2], B1[2][2];
    const char* cA = a_ptr(g, cur); const char* cB = b_ptr(g, cur);
    PG8_STAGE(PG8_SB(0, 0), cB, voffB); PG8_STAGE(PG8_SB(0, 1), cB + hstepB, voffB); PG8_STAGE(PG8_SA(0, 0), cA, voffA); PG8_STAGE(PG8_SA(0, 1), cA + hstepA, voffA);
    if (wr == 1) PG8_BAR;
    PG8_WAIT_V(2); PG8_BAR;
    PG8_STAGE(PG8_SB(1, 0), cB + kstep, voffB); PG8_STAGE(PG8_SA(1, 0), cA + kstep, voffA); PG8_STAGE(PG8_SB(1, 1), cB + hstepB + kstep, voffB);
    PG8_WAIT_V(6); PG8_BAR;
    for (;;) {
        const bool has_next = S.next(ui + 1, nxt);
        const char* nA = has_next ? a_ptr(g, nxt) : cA; const char* nB = has_next ? b_ptr(g, nxt) : cB;
        for (int t = 0; t < nt; t += 2) {
            const bool last = (t == nt - 2);
            const char* a1 = cA + (size_t)(t + 1) * kstep;
            const char* a2 = last ? nA : cA + (size_t)(t + 2) * kstep; const char* b2 = last ? nB : cB + (size_t)(t + 2) * kstep;
            const char* a3 = a2 + kstep; const char* b3 = b2 + kstep;
            PG8_LDB(B0, 0, 0); PG8_LDB(B1, 0, 1); PG8_SCHED; PG8_LDA(At, 0, 0); PG8_STAGE(PG8_SA(1, 1), a1 + hstepA, voffA);
            PG8_WAIT_V(8); PG8_WAIT_L(0); PG8_BAR; PG8_MMA(0, 0, At, B0); PG8_MMA(0, 1, At, B1); PG8_BAR; PG8_SCHED;
            PG8_LDA(At, 0, 1); PG8_STAGE(PG8_SB(0, 0), b2, voffB); PG8_STAGE(PG8_SB(0, 1), b2 + hstepB, voffB); PG8_STAGE(PG8_SA(0, 0), a2, voffA);
            PG8_WAIT_V(8); PG8_WAIT_L(0); PG8_BAR; PG8_MMA(1, 0, At, B0); PG8_MMA(1, 1, At, B1); PG8_BAR; PG8_SCHED;
            PG8_LDB(B0, 1, 0); PG8_LDB(B1, 1, 1); PG8_SCHED; PG8_LDA(At, 1, 0); PG8_STAGE(PG8_SA(0, 1), a2 + hstepA, voffA);
            PG8_WAIT_V(8); PG8_WAIT_L(0); PG8_BAR; PG8_MMA(0, 0, At, B0); PG8_MMA(0, 1, At, B1); PG8_BAR; PG8_SCHED;
            PG8_LDA(At, 1, 1); PG8_STAGE(PG8_SB(1, 0), b3, voffB); PG8_STAGE(PG8_SB(1, 1), b3 + hstepB, voffB); PG8_STAGE(PG8_SA(1, 0), a3, voffA);
            PG8_WAIT_V(8); PG8_WAIT_L(0); PG8_BAR; PG8_MMA(1, 0, At, B0); PG8_MMA(1, 1, At, B1); PG8_BAR; PG8_SCHED;
        }
        if constexpr (ALIGN_EPI) { if (wr == 0) PG8_BAR; }
        PG8_SCHED;
        if constexpr (!Epi::AFTER_DRAIN) { E(acc, cur, wr, wc, fr, fq, lds, wid, lane); }
        PG8_SCHED;
        if (!has_next) break;
#pragma unroll
        for (int a = 0; a < 2; ++a)
#pragma unroll
            for (int b = 0; b < 2; ++b)
#pragma unroll
                for (int m = 0; m < 4; ++m)
#pragma unroll
                    for (int n = 0; n < 2; ++n) acc[a][b][m][n] = (f32x4){0.f, 0.f, 0.f, 0.f};
        cur = nxt; cA = nA; cB = nB; ++ui;
        if constexpr (ALIGN_EPI) { if (wr == 1) PG8_BAR; }
    }
    PG8_WAIT_V(0);
    if constexpr (!ALIGN_EPI) { if (wr == 0) PG8_BAR; }
    PG8_BAR;
    if constexpr (Epi::AFTER_DRAIN) { E(acc, cur, wr, wc, fr, fq, lds, wid, lane); }
#undef PG8_SA
#undef PG8_SB
#undef PG8_STAGE
#undef PG8_LDA
#undef PG8_LDB
#undef PG8_MMA
#undef PG8_WAIT_V
#undef PG8_WAIT_L
#undef PG8_SCHED
}
#define EPI_BAR() do { asm volatile("s_waitcnt lgkmcnt(0)" ::: "memory"); __builtin_amdgcn_s_barrier(); asm volatile("" ::: "memory"); } while (0)

struct EpiBf16 {
    static constexpr bool PERM = true, AFTER_DRAIN = false;
    bf16_t* O; int ldc; long o_zb, o_zh;
    __device__ __forceinline__ void operator()(const f32x4 (&acc)[2][2][4][2], const Unit& u, int wr, int wc, int fr, int fq, LAS unsigned char*, int, int) const {
        bf16_t* base = O + u.zb * o_zb + u.zh * o_zh;
        const int row0 = u.pm * BM + wr * 64 + fr, col0 = u.pn * BM + wc * 32 + 8 * fq;
#pragma unroll
        for (int ai = 0; ai < 2; ++ai)
#pragma unroll
            for (int m = 0; m < 4; ++m) { bf16_t* rowp = base + (size_t)(row0 + ai * HALF + m * 16) * ldc + col0;
#pragma unroll
                for (int bj = 0; bj < 2; ++bj) { const f32x4 v0 = acc[ai][bj][m][0], v1 = acc[ai][bj][m][1];
                    u32x4 w; w.x = pk2(v0[0], v0[1]); w.y = pk2(v0[2], v0[3]); w.z = pk2(v1[0], v1[1]); w.w = pk2(v1[2], v1[3]);
                    *(u32x4*)(rowp + bj * HALF) = w; } }
    }
};
struct EpiInProj {
    static constexpr bool PERM = true, AFTER_DRAIN = false;
    bf16_t* da; bf16_t* hg; float* logf; const float* lbraw;
    __device__ __forceinline__ void operator()(const f32x4 (&acc)[2][2][4][2], const Unit& u, int wr, int wc, int fr, int fq, LAS unsigned char*, int, int) const {
        const int seg = u.pn >> 2, colt = (u.pn & 3) * BM;
        const int row0 = u.pm * BM + wr * 64 + fr, col0 = colt + wc * 32 + 8 * fq;
        if (seg == 4) {
            float lb[2][8];
#pragma unroll
            for (int bj = 0; bj < 2; ++bj) { const f32x4 r0a = *(const f32x4*)(lbraw + col0 + bj * HALF), r0b = *(const f32x4*)(lbraw + col0 + bj * HALF + 4);
                const f32x4 r1a = *(const f32x4*)(lbraw + 1024 + col0 + bj * HALF), r1b = *(const f32x4*)(lbraw + 1024 + col0 + bj * HALF + 4);
#pragma unroll
                for (int j = 0; j < 4; ++j) { lb[bj][j] = frcp(1.f + fexp(r1a[j] - r0a[j])); lb[bj][4 + j] = frcp(1.f + fexp(r1b[j] - r0b[j])); } }
#pragma unroll
            for (int ai = 0; ai < 2; ++ai)
#pragma unroll
                for (int m = 0; m < 4; ++m) { float* rowp = logf + (size_t)(row0 + ai * HALF + m * 16) * 1024 + col0;
#pragma unroll
                    for (int bj = 0; bj < 2; ++bj)
#pragma unroll
                        for (int n = 0; n < 2; ++n) { const f32x4 v = acc[ai][bj][m][n]; f32x4 o;
#pragma unroll
                            for (int j = 0; j < 4; ++j) { const float l = lb[bj][4 * n + j], sg = frcp(1.f + fexp(-v[j])); o[j] = __builtin_amdgcn_logf(l + (1.f - l) * sg) * 0.6931471805599453f; }
                            *(f32x4*)(rowp + bj * HALF + 4 * n) = o; } }
        } else {
            bf16_t* base = seg < 3 ? da + (size_t)seg * SEG : hg + (size_t)(seg == 3 ? 0 : seg - 4) * SEG;
            const float sc = seg == 0 ? C2_DA : 1.f;
#pragma unroll
            for (int ai = 0; ai < 2; ++ai)
#pragma unroll
                for (int m = 0; m < 4; ++m) { bf16_t* rowp = base + (size_t)(row0 + ai * HALF + m * 16) * 1024 + col0;
#pragma unroll
                    for (int bj = 0; bj < 2; ++bj) { const f32x4 v0 = acc[ai][bj][m][0] * sc, v1 = acc[ai][bj][m][1] * sc;
                        u32x4 w; w.x = pk2(v0[0], v0[1]); w.y = pk2(v0[2], v0[3]); w.z = pk2(v1[0], v1[1]); w.w = pk2(v1[2], v1[3]);
                        *(u32x4*)(rowp + bj * HALF) = w; } }
        }
    }
};
template <bool WRITE_BF16> struct EpiResid {
    static constexpr bool PERM = false, AFTER_DRAIN = true;
    const float* xold; float* xnew; bf16_t* xb; float* rss;
    __device__ __forceinline__ void operator()(f32x4 (&acc)[2][2][4][2], const Unit& u, int wr, int wc, int fr, int fq, LAS unsigned char* lds, int, int) const {
        LAS float* P = (LAS float*)lds;
        const int col0 = u.pn * BM + wc * 32 + 4 * fq;
#pragma unroll
        for (int ai = 0; ai < 2; ++ai)
#pragma unroll
            for (int m = 0; m < 4; ++m) { const int rl = ai * HALF + wr * 64 + m * 16 + fr; const size_t off = (size_t)(u.pm * BM + rl) * DM + col0; float ss = 0.f;
#pragma unroll
                for (int bj = 0; bj < 2; ++bj)
#pragma unroll
                    for (int n = 0; n < 2; ++n) { const f32x4 xo = *(const f32x4*)(xold + off + bj * HALF + n * 16); const f32x4 v = xo + acc[ai][bj][m][n];
                        *(f32x4*)(xnew + off + bj * HALF + n * 16) = v;
                        if (WRITE_BF16) { u32x2 w; w.x = pk2(v[0], v[1]); w.y = pk2(v[2], v[3]); *(u32x2*)(xb + off + bj * HALF + n * 16) = w; }
                        ss += (v[0] * v[0] + v[1] * v[1]) + (v[2] * v[2] + v[3] * v[3]); }
                ss += __shfl_xor(ss, 16); ss += __shfl_xor(ss, 32);
                if (fq == 0) P[rl * 4 + wc] = ss;
                asm volatile("" ::: "memory"); }
        EPI_BAR();
        const int t = threadIdx.x;
        if (t < 256) { const f32x4 p = *(const LAS f32x4*)(P + t * 4); rss[(size_t)(u.pm * BM + t) * 8 + u.pn] = (p[0] + p[1]) + (p[2] + p[3]); }
    }
};
__device__ __forceinline__ float row_rinv(const float* rss, int row) {
    const f32x4 a = *(const f32x4*)(rss + (size_t)row * 8), b = *(const f32x4*)(rss + (size_t)row * 8 + 4);
    const float s = ((a[0] + a[1]) + (a[2] + a[3])) + ((b[0] + b[1]) + (b[2] + b[3]));
    return __builtin_amdgcn_rsqf(s * (1.0f / DM) + EPS);
}
struct EpiSoftmax {
    static constexpr bool PERM = true, AFTER_DRAIN = true;
    const float* rss; bf16_t* Pout;
    __device__ __forceinline__ void operator()(f32x4 (&acc)[2][2][4][2], const Unit& u, int wr, int wc, int fr, int fq, LAS unsigned char* lds, int, int) const {
        LAS float* Pm = (LAS float*)lds; LAS float* Ps = (LAS float*)(lds + 4096);
#pragma unroll
        for (int ai = 0; ai < 2; ++ai)
#pragma unroll
            for (int m = 0; m < 4; ++m) { const int rl = ai * HALF + wr * 64 + m * 16 + fr; const float ri = row_rinv(rss, u.pm * BM + rl); float mx = -INFINITY;
#pragma unroll
                for (int bj = 0; bj < 2; ++bj)
#pragma unroll
                    for (int n = 0; n < 2; ++n) { f32x4 v = acc[ai][bj][m][n] * ri; acc[ai][bj][m][n] = v; mx = fmaxf(mx, fmaxf(fmaxf(v[0], v[1]), fmaxf(v[2], v[3]))); }
                mx = fmaxf(mx, __shfl_xor(mx, 16)); mx = fmaxf(mx, __shfl_xor(mx, 32));
                if (fq == 0) Pm[rl * 4 + wc] = mx; }
        EPI_BAR();
#pragma unroll
        for (int ai = 0; ai < 2; ++ai)
#pragma unroll
            for (int m = 0; m < 4; ++m) { const int rl = ai * HALF + wr * 64 + m * 16 + fr; const f32x4 pm4 = *(const LAS f32x4*)(Pm + rl * 4);
                const float mx = fmaxf(fmaxf(pm4[0], pm4[1]), fmaxf(pm4[2], pm4[3])); float sm = 0.f;
#pragma unroll
                for (int bj = 0; bj < 2; ++bj)
#pragma unroll
                    for (int n = 0; n < 2; ++n) { f32x4 v = acc[ai][bj][m][n];
#pragma unroll
                        for (int j = 0; j < 4; ++j) { v[j] = fexp2(v[j] - mx); sm += v[j]; }
                        acc[ai][bj][m][n] = v; }
                sm += __shfl_xor(sm, 16); sm += __shfl_xor(sm, 32);
                if (fq == 0) Ps[rl * 4 + wc] = sm; }
        EPI_BAR();
        const int col0 = u.pn * BM + wc * 32 + 8 * fq;
#pragma unroll
        for (int ai = 0; ai < 2; ++ai)
#pragma unroll
            for (int m = 0; m < 4; ++m) { const int rl = ai * HALF + wr * 64 + m * 16 + fr; const f32x4 ps4 = *(const LAS f32x4*)(Ps + rl * 4);
                const float il = frcp((ps4[0] + ps4[1]) + (ps4[2] + ps4[3])); bf16_t* rowp = Pout + (size_t)(u.pm * BM + rl) * 1024 + col0;
#pragma unroll
                for (int bj = 0; bj < 2; ++bj) { const f32x4 v0 = acc[ai][bj][m][0] * il, v1 = acc[ai][bj][m][1] * il;
                    u32x4 w; w.x = pk2(v0[0], v0[1]); w.y = pk2(v0[2], v0[3]); w.z = pk2(v1[0], v1[1]); w.w = pk2(v1[2], v1[3]);
                    *(u32x4*)(rowp + bj * HALF) = w; } }
    }
};
template <int CTRL> __device__ __forceinline__ unsigned dpp_upd(unsigned old, unsigned src) {
    return (unsigned)__builtin_amdgcn_update_dpp((int)old, (int)src, CTRL, 0xF, 0xF, false);
}
template <int CTRL> __device__ __forceinline__ unsigned dpp_rot(unsigned src) { return (unsigned)__builtin_amdgcn_mov_dpp((int)src, CTRL, 0xF, 0xF, true); }
struct EpiUp {
    static constexpr bool PERM = true, AFTER_DRAIN = false;
    const float* rss; const float* cw; const float* cb; bf16_t* G; bf16_t* Y4;
    __device__ __forceinline__ void operator()(f32x4 (&acc)[2][2][4][2], const Unit& u, int wr, int wc, int fr, int fq, LAS unsigned char* lds, int wid, int lane) const {
        LAS unsigned* HX = (LAS unsigned*)(lds + SPARE_OFF);
        { int l_; asm volatile("v_mbcnt_lo_u32_b32 %0, -1, 0\n\tv_mbcnt_hi_u32_b32 %0, -1, %0" : "=v"(l_)); fr = l_ & 15; fq = l_ >> 4; }
        u32x2 yp[2][2][4][2];
#pragma unroll
        for (int ai = 0; ai < 2; ++ai)
#pragma unroll
            for (int m = 0; m < 4; ++m) { const float ri = row_rinv(rss, u.pm * BM + ai * HALF + wr * 64 + m * 16 + fr);
#pragma unroll
                for (int bj = 0; bj < 2; ++bj)
#pragma unroll
                    for (int n = 0; n < 2; ++n) { const f32x4 v = acc[ai][bj][m][n] * ri; yp[ai][bj][m][n] = (u32x2){pk2(v[0], v[1]), pk2(v[2], v[3])}; }
                asm volatile("" : "+v"(yp[ai][0][m][0]), "+v"(yp[ai][0][m][1]), "+v"(yp[ai][1][m][0]), "+v"(yp[ai][1][m][1]) :: "memory"); }
        const int clw = 4 * fq;
        const int colg = u.pn * HALF + wc * 32 + 8 * fq;
        if (fr >= 14) {
#pragma unroll
            for (int ai = 0; ai < 2; ++ai)
#pragma unroll
                for (int bj = 0; bj < 2; ++bj) *(LAS u32x4*)(HX + ((wid * 2 + ai) * 2 + (fr - 14)) * 32 + bj * 16 + clw) = (u32x4){yp[ai][bj][3][0].x, yp[ai][bj][3][0].y, yp[ai][bj][3][1].x, yp[ai][bj][3][1].y};
            if (wr == 1) {
#pragma unroll
                for (int bj = 0; bj < 2; ++bj) *(u32x4*)(Y4 + (unsigned)((u.pm * 4 + 2 + (fr - 14)) * (2 * DFF) + bj * DFF + colg)) = (u32x4){yp[1][bj][3][0].x, yp[1][bj][3][0].y, yp[1][bj][3][1].x, yp[1][bj][3][1].y};
            }
        }
        if (fr < 2 && wr == 0) {
#pragma unroll
            for (int bj = 0; bj < 2; ++bj) *(u32x4*)(Y4 + (unsigned)((u.pm * 4 + fr) * (2 * DFF) + bj * DFF + colg)) = (u32x4){yp[0][bj][0][0].x, yp[0][bj][0][0].y, yp[0][bj][0][1].x, yp[0][bj][0][1].y};
        }
        EPI_BAR();
#pragma unroll
        for (int ai = 0; ai < 2; ++ai) {
            const bool tile_top = (ai == 0 && wr == 0);
            const int pw = (wr == 1) ? wc : 4 + wc, pai = (wr == 1) ? ai : 0;
            const LAS unsigned* hp = HX + ((pw * 2 + pai) * 2) * 32;
            u32x4 outw[4];
            int colg_a = colg; asm volatile("" : "+v"(colg_a));
#pragma unroll
            for (int n = 0; n < 2; ++n) {
                float ua[4][4];
#pragma unroll
                for (int bj = 0; bj < 2; ++bj) {
                    const unsigned c = (unsigned)(bj * DFF + colg_a + 4 * n);
                    const f32x4 w0 = *(const f32x4*)(cw + c), w1 = *(const f32x4*)(cw + (2 * DFF + c)), w2 = *(const f32x4*)(cw + (4 * DFF + c)), bb = *(const f32x4*)(cb + c);
                    u32x2 h2 = (u32x2){0u, 0u}, h1 = h2;
                    if (!tile_top) { h2 = *(const LAS u32x2*)(hp + bj * 16 + clw + 2 * n); h1 = *(const LAS u32x2*)(hp + 32 + bj * 16 + clw + 2 * n); }
#pragma unroll
                    for (int m = 0; m < 4; ++m) {
                        float gg[4];
#pragma unroll
                        for (int j2 = 0; j2 < 2; ++j2) {
                            const unsigned x = yp[ai][bj][m][n][j2];
                            unsigned o1, o2;
                            if (m == 0) { o1 = h1[j2]; o2 = (fr == 0) ? h2[j2] : h1[j2]; }
                            else { const unsigned xp = yp[ai][bj][m - 1][n][j2]; o1 = dpp_rot<0x121>(xp); o2 = dpp_rot<0x122>(xp); }
                            const unsigned p1 = dpp_upd<0x111>(o1, x), p2 = dpp_upd<0x112>(o2, x);
                            const float u0 = bb[2 * j2] + w0[2 * j2] * bflo(p2) + w1[2 * j2] * bflo(p1) + w2[2 * j2] * bflo(x);
                            const float u1 = bb[2 * j2 + 1] + w0[2 * j2 + 1] * bfhi(p2) + w1[2 * j2 + 1] * bfhi(p1) + w2[2 * j2 + 1] * bfhi(x);
                            if (bj == 0) { ua[m][2 * j2] = u0; ua[m][2 * j2 + 1] = u1; }
                            else { gg[2 * j2] = ua[m][2 * j2] * frcp(1.f + fexp(-ua[m][2 * j2])) * u0; gg[2 * j2 + 1] = ua[m][2 * j2 + 1] * frcp(1.f + fexp(-ua[m][2 * j2 + 1])) * u1; }
                        }
                        if (bj == 1) { if (n == 0) { outw[m].x = pk2(gg[0], gg[1]); outw[m].y = pk2(gg[2], gg[3]); } else { outw[m].z = pk2(gg[0], gg[1]); outw[m].w = pk2(gg[2], gg[3]); } }
                    }
                    asm volatile("" ::: "memory");
                }
            }
#pragma unroll
            for (int m = 0; m < 4; ++m) *(u32x4*)(G + (unsigned)((u.pm * BM + ai * HALF + wr * 64 + m * 16 + fr) * DFF + colg)) = outw[m];
            asm volatile("" ::: "memory");
        }
    }
};
}

#define XB_TMO      128
#define XB_XCNT(j)  (256  + 64 * (j))
#define XB_XSUB(j)  (1280 + 64 * (j))
#define XB_XGEN(j)  (2304 + 64 * (j))
#define XB_TOP      3328
#define XB_TOPGEN   3392
#define XCD_BAR_WORDS 3456
#define XB_SPIN_CAP (1u << 22)
__device__ __forceinline__ unsigned xb_ld(unsigned* p)              { return __hip_atomic_load(p, __ATOMIC_RELAXED, __HIP_MEMORY_SCOPE_AGENT); }
__device__ __forceinline__ unsigned xb_add(unsigned* p, unsigned v) { return __hip_atomic_fetch_add(p, v, __ATOMIC_RELAXED, __HIP_MEMORY_SCOPE_AGENT); }
__device__ __forceinline__ unsigned xb_xcc_id() { return (unsigned)__builtin_amdgcn_s_getreg((3 << 11) | 20) & 0xFu; }
#define XB_SPIN(cond, bar) do { unsigned _sp = 0; while (cond) { __builtin_amdgcn_s_sleep(1); \
    if ((++_sp & 255u) == 0u) { if (xb_ld(&(bar)[XB_TMO])) break; if (_sp > XB_SPIN_CAP) { atomicAdd(&(bar)[XB_TMO], 1u); break; } } } } while (0)
struct XcdBarrier { unsigned* bar; unsigned x; volatile LAS unsigned* st; };
__device__ __forceinline__ XcdBarrier xcd_barrier_post(unsigned* bar, volatile LAS unsigned* st) {
    XcdBarrier b; b.bar = bar; b.x = xb_xcc_id(); b.st = st;
    if (threadIdx.x == 0) (void)xb_add(&bar[XB_XCNT(b.x)], 1u);
    return b;
}
__device__ __forceinline__ void xcd_barrier_complete(unsigned* bar, unsigned x, unsigned& nloc, unsigned& nx) {
    const unsigned G = gridDim.x * gridDim.y * gridDim.z;
    unsigned sum, cnt, mine, sp = 0u;
    for (;;) {
        sum = 0u; cnt = 0u; mine = 0u;
#pragma unroll
        for (unsigned j = 0; j < 16; ++j) { const unsigned c = xb_ld(&bar[XB_XCNT(j)]); sum += c; cnt += (c > 0u) ? 1u : 0u; mine = (j == x) ? c : mine; }
        if (sum == G) break;
        __builtin_amdgcn_s_sleep(1);
        if ((++sp & 255u) == 0u) { if (xb_ld(&bar[XB_TMO])) break; if (sp > XB_SPIN_CAP) { atomicAdd(&bar[XB_TMO], 1u); break; } }
    }
    nloc = mine > 0u ? mine : 1u; nx = cnt > 0u ? cnt : 1u;
}
__device__ __forceinline__ void xcd_barrier(const XcdBarrier& b) {
    asm volatile("s_waitcnt vmcnt(0)" ::: "memory");
    __syncthreads();
    if (threadIdx.x == 0) {
        unsigned* bar = b.bar;
        __builtin_amdgcn_s_waitcnt(0);
        unsigned nloc = b.st[0], nx = b.st[1];
        if (nloc == 0u) { xcd_barrier_complete(bar, b.x, nloc, nx); b.st[0] = nloc; b.st[1] = nx; }
        const unsigned old = xb_add(&bar[XB_XSUB(b.x)], 1u);
        const unsigned gen = old / nloc;
        if (old + 1u == (gen + 1u) * nloc) {
            __builtin_amdgcn_fence(__ATOMIC_RELEASE, "agent");
            asm volatile("s_waitcnt vmcnt(0)" ::: "memory");
            const unsigned og = xb_add(&bar[XB_TOP], 1u);
            const unsigned tg = og / nx;
            if (og + 1u == (tg + 1u) * nx) xb_add(&bar[XB_TOPGEN], 1u);
            else XB_SPIN(xb_ld(&bar[XB_TOPGEN]) == tg, bar);
            __builtin_amdgcn_fence(__ATOMIC_ACQUIRE, "agent");
            xb_add(&bar[XB_XGEN(b.x)], 1u);
            asm volatile("s_waitcnt vmcnt(0)" ::: "memory");
        } else {
            XB_SPIN(xb_ld(&bar[XB_XGEN(b.x)]) == gen, bar);
            __builtin_amdgcn_fence(__ATOMIC_ACQUIRE, "agent");
            asm volatile("s_waitcnt vmcnt(0)" ::: "memory");
        }
    }
    __syncthreads();
}

struct Args {
    const float *x, *mem, *w_in, *w_out, *norm_mix_w, *lam_q1, *lam_k1, *lam_q2, *lam_k2, *da_subln_w, *hg_lb_raw, *hg_norm_w, *rel_bias, *norm_mem_w, *mem_kv_norm_w,
        *w_mq, *w_mkv, *w_mo, *norm_ffn_w, *w_up, *conv_w, *conv_b, *w_down, *final_norm_w;
    float* out; unsigned char* ws; int ph_lo, ph_hi;
};
struct Ctx { LAS unsigned char* lds; int tid, lane, wave, vcu, G; };

__device__ __forceinline__ Ctx fresh(const Ctx& F0) {
    Ctx F = F0; int t = threadIdx.x; asm volatile("" : "+v"(t)); F.tid = t; F.lane = t & 63; F.wave = __builtin_amdgcn_readfirstlane(t >> 6); return F;
}
__device__ __forceinline__ void cvt_item(const float* W, int K, int N, bf16_t* WT, const float* rs, LAS unsigned char* scr, int item, int lane) {
    const int nblk = N / 32, kb = item / nblk, nb = item % nblk, k0 = 64 * kb, n0 = 32 * nb, c = lane >> 3, nq = lane & 7;
    const float* src = W + (size_t)(k0 + 8 * c) * N + n0 + 4 * nq;
    f32x4 v[8];
#pragma unroll
    for (int i = 0; i < 8; ++i) v[i] = *(const f32x4*)(src + (size_t)i * N);
    if (rs) { const f32x4 r0 = *(const f32x4*)(rs + k0 + 8 * c), r1 = *(const f32x4*)(rs + k0 + 8 * c + 4);
#pragma unroll
        for (int i = 0; i < 4; ++i) { v[i] = v[i] * r0[i]; v[4 + i] = v[4 + i] * r1[i]; } }
    LAS unsigned char* wslot = scr + ((c * 8 + (nq ^ c)) << 4);
#pragma unroll
    for (int j = 0; j < 4; ++j) { u32x4 o; o.x = pk2(v[0][j], v[1][j]); o.y = pk2(v[2][j], v[3][j]); o.z = pk2(v[4][j], v[5][j]); o.w = pk2(v[6][j], v[7][j]);
        *(LAS u32x4*)(wslot + j * 1024) = o; }
    LDS_WAIT(); asm volatile("" ::: "memory");
    const LAS unsigned char* rslot = scr + ((nq * 8 + (c ^ nq)) << 4);
    bf16_t* dst = WT + (size_t)(n0 + 4 * c) * K + k0 + 8 * nq;
#pragma unroll
    for (int j = 0; j < 4; ++j) { const u32x4 o = *(const LAS u32x4*)(rslot + j * 1024); *(u32x4*)(dst + (size_t)j * K) = o; }
    LDS_WAIT(); asm volatile("" ::: "memory");
}
__device__ __forceinline__ void cvt_matrix(const float* W, int K, int N, bf16_t* WT, const float* rs, int w, int nw, const Ctx& F) {
    const int nitems = (K / 64) * (N / 32);
    LAS unsigned char* scr = F.lds + F.wave * 4096;
    for (int it = w; it < nitems; it += nw) cvt_item(W, K, N, WT, rs, scr, it, F.lane);
}
__device__ __forceinline__ void cvt_wmq(const float* w_mq, const float* gain, bf16_t* o, int t, int nt) {
    const int nvec = DM * DM / 8;
    for (int i = t; i < nvec; i += nt) { const int k = i / (DM / 8); const float sc = gain[k] * C2_MEM;
        const f32x4 v0 = __builtin_nontemporal_load((const f32x4*)(w_mq + (size_t)i * 8)), v1 = __builtin_nontemporal_load((const f32x4*)(w_mq + (size_t)i * 8 + 4));
        u32x4 w; w.x = pk2(v0[0] * sc, v0[1] * sc); w.y = pk2(v0[2] * sc, v0[3] * sc); w.z = pk2(v1[0] * sc, v1[1] * sc); w.w = pk2(v1[2] * sc, v1[3] * sc);
        *(u32x4*)(o + (size_t)i * 8) = w; }
}
__device__ __forceinline__ void rms_row_to_bf16(const float* xrow, const float* gain, bf16_t* orow, int lane) {
    const f32x4* xr = (const f32x4*)xrow + lane; const f32x4* gr = (const f32x4*)gain + lane;
    f32x4 v[8]; float s = 0.f;
#pragma unroll
    for (int j = 0; j < 8; ++j) { v[j] = xr[64 * j]; s += (v[j][0] * v[j][0] + v[j][1] * v[j][1]) + (v[j][2] * v[j][2] + v[j][3] * v[j][3]); }
    const float r = __builtin_amdgcn_rsqf(wave_sum(s) * (1.f / DM) + EPS);
    u32x2* o8 = (u32x2*)orow + lane;
#pragma unroll
    for (int j = 0; j < 8; ++j) { const f32x4 gq = gr[64 * j]; u32x2 w; w.x = pk2(v[j][0] * r * gq[0], v[j][1] * r * gq[1]); w.y = pk2(v[j][2] * r * gq[2], v[j][3] * r * gq[3]); o8[64 * j] = w; }
}
__device__ __forceinline__ void cvt_p1(const Ctx& F, const Args& a, int w, int nw) {
    cvt_matrix(a.w_mo, DM, DM, (bf16_t*)(a.ws + WS_WMO), nullptr, w, nw, F);
    cvt_wmq(a.w_mq, a.norm_mem_w, (bf16_t*)(a.ws + WS_WMQ), w * 64 + F.lane, nw * 64);
    cvt_matrix(a.w_out, DM, DM, (bf16_t*)(a.ws + WS_WOUT), nullptr, w, nw, F);
}
__device__ __forceinline__ void cvt_up(const Ctx& F, const Args& a, int w, int nw) { cvt_matrix(a.w_up, DM, 2 * DFF, (bf16_t*)(a.ws + WS_WUP), a.norm_ffn_w, w, nw, F); }
__device__ __forceinline__ void cvt_down(const Ctx& F, const Args& a, int w, int nw) { cvt_matrix(a.w_down, DFF, DM, (bf16_t*)(a.ws + WS_WDOWN), nullptr, w, nw, F); }
__device__ __forceinline__ void p0_prologue(const Ctx& F, const Args& a, bool defer) {
    unsigned char* ws = a.ws;
    const int gw = F.vcu * NWAVES + F.wave, NGW = F.G * NWAVES;
    cvt_matrix(a.w_in, DM, DIN, (bf16_t*)(ws + WS_WIN), nullptr, gw, NGW, F);
    for (int m = gw; m < MROWS; m += NGW) rms_row_to_bf16(a.x + (size_t)m * DM, a.norm_mix_w, (bf16_t*)(ws + WS_A1) + (size_t)m * DM, F.lane);
    for (int m = gw; m < BATCH * NMEM; m += NGW) rms_row_to_bf16(a.mem + (size_t)m * DM, a.mem_kv_norm_w, (bf16_t*)(ws + WS_MK) + (size_t)m * DM, F.lane);
    cvt_matrix(a.w_mkv, DM, 2 * DM, (bf16_t*)(ws + WS_WMKV), nullptr, gw, NGW, F);
    if (!defer) { cvt_p1(F, a, gw, NGW); cvt_up(F, a, gw, NGW); cvt_down(F, a, gw, NGW); }
}

namespace att {
constexpr int KSLOT = 8192, VSLOT = 16384, L_K = 0, L_V = 2 * KSLOT, L_TB = L_V + 2 * VSLOT, L_WS = L_TB + 1024;
__device__ __forceinline__ void unit(const Ctx& F, int b, int h, int map, int qb, const bf16_t* Q, const bf16_t* Kt, const bf16_t* Vt, bf16_t* O, const float* rel_bias) {
    LAS unsigned char* lds = F.lds;
    const int lane = F.lane, wid = F.wave, r32 = lane & 31, hi = lane >> 5;
    LAS float* tb = (LAS float*)(lds + L_TB);
    LAS float* wsf = (LAS float*)(lds + L_WS) + wid * 64;
    __syncthreads();
    if (F.tid < 129) tb[F.tid] = rel_bias[(int)T5_BUCKET[F.tid] * 8 + h] * LOG2E;
    const long rowbase = (long)b * SEQ; const int qw0 = qb * 256 + wid * 32;
    const bf16_t* Kh = Kt + rowbase * 1024 + h * 128 + map * 64;
    const bf16_t* Vh = Vt + rowbase * 1024 + h * 128;
    bf16x8 qr[4];
    { const bf16_t* qp = Q + (rowbase + qw0 + r32) * 1024 + h * 128 + map * 64 + hi * 8;
#pragma unroll
      for (int d0 = 0; d0 < 4; ++d0) qr[d0] = *(const bf16x8*)(qp + d0 * 16); }
    const int NT = 4 * qb + 4, tmax = 4 * qb + (wid >> 1);
    const bf16_t* ksrc = Kh + (long)lane * 1024 + wid * 8;
    const int p0i = wid, p1i = wid + 8;
    const bf16_t* vsrc0 = Vh + (long)(16 * (p0i & 3) + (lane >> 2)) * 1024 + (p0i >> 2) * 32 + (lane & 3) * 8;
    const bf16_t* vsrc1 = Vh + (long)(16 * (p1i & 3) + (lane >> 2)) * 1024 + (p1i >> 2) * 32 + (lane & 3) * 8;
#define ATT_ISSUE(t, s) do { glds16(ksrc + (long)(t) * 64 * 1024, lds + L_K + (s) * KSLOT + wid * 1024); \
        glds16(vsrc0 + (long)(t) * 64 * 1024, lds + L_V + (s) * VSLOT + p0i * 1024); glds16(vsrc1 + (long)(t) * 64 * 1024, lds + L_V + (s) * VSLOT + p1i * 1024); } while (0)
    f32x16 o[4];
#pragma unroll
    for (int d = 0; d < 4; ++d) o[d] = (f32x16){};
    float mrun = -INFINITY, lrun = 0.f;
    const float tb_far = rel_bias[31 * 8 + h] * LOG2E;
    ATT_ISSUE(0, 0);
    for (int t = 0; t < NT; ++t) {
        VM_WAIT(); __syncthreads();
        if (t + 1 < NT) ATT_ISSUE(t + 1, (t + 1) & 1);
        if (t > tmax) continue;
        const int s = t & 1, k0 = t * 64;
        const bool far = (k0 + 63 + 128 <= qw0);
        f32x16 p0, p1;
        { const float ini = far ? tb_far : 0.f;
#pragma unroll
          for (int r = 0; r < 16; ++r) { p0[r] = ini; p1[r] = ini; } }
        const LAS unsigned char* kb = lds + L_K + s * KSLOT + hi * 1024 + r32 * 16;
#pragma unroll
        for (int d0 = 0; d0 < 4; ++d0) {
            const bf16x8 b0 = *(const LAS bf16x8*)(kb + d0 * 2048), b1 = *(const LAS bf16x8*)(kb + d0 * 2048 + 512);
            p0 = __builtin_amdgcn_mfma_f32_32x32x16_bf16(b0, qr[d0], p0, 0, 0, 0);
            p1 = __builtin_amdgcn_mfma_f32_32x32x16_bf16(b1, qr[d0], p1, 0, 0, 0);
        }
        if (!far) {
            const int base = qw0 + r32 - k0 - 4 * hi;
#pragma unroll
            for (int r = 0; r < 16; ++r) { const int rel0 = base - ((r & 3) + 8 * (r >> 2)), rel1 = rel0 - 32;
                const int i0 = rel0 < 0 ? 0 : (rel0 > 128 ? 128 : rel0), i1 = rel1 < 0 ? 0 : (rel1 > 128 ? 128 : rel1);
                p0[r] = rel0 < 0 ? -INFINITY : p0[r] + tb[i0]; p1[r] = rel1 < 0 ? -INFINITY : p1[r] + tb[i1]; }
        }
        float rm = fmaxf(p0[0], p1[0]);
#pragma unroll
        for (int r = 1; r < 16; ++r) rm = fmaxf(rm, fmaxf(p0[r], p1[r]));
        rm = fmaxf(rm, __shfl_xor(rm, 32));
        if (__any(rm > mrun + 8.0f)) {
            const float mn = fmaxf(mrun, rm), al = fexp2(mrun - mn);
            mrun = mn; lrun *= al;
            if (hi == 0) wsf[r32] = al;
            LDS_WAIT();
#pragma unroll
            for (int g4 = 0; g4 < 4; ++g4) { const f32x4 a4 = *(const LAS f32x4*)(wsf + 8 * g4 + 4 * hi);
#pragma unroll
                for (int d = 0; d < 4; ++d)
#pragma unroll
                    for (int j = 0; j < 4; ++j) o[d][4 * g4 + j] *= a4[j]; }
        }
        float sm = 0.f;
#pragma unroll
        for (int r = 0; r < 16; ++r) { p0[r] = fexp2(p0[r] - mrun); p1[r] = fexp2(p1[r] - mrun); sm += p0[r] + p1[r]; }
        lrun += sm;
        const bf16x8 pa0 = pack8(p0, 0), pa1 = pack8(p0, 8), pa2 = pack8(p1, 0), pa3 = pack8(p1, 8);
        const LAS unsigned char* vp = lds + L_V + s * VSLOT + ((lane >> 4) & 1) * 32 + (lane & 3) * 8 + (4 * hi + ((lane & 15) >> 2)) * 64;
#pragma unroll
        for (int d0 = 0; d0 < 4; ++d0) {
            const bf16x8 v0 = cat8(vtr(vp + d0 * 4096), vtr(vp + d0 * 4096 + 512));
            const bf16x8 v1 = cat8(vtr(vp + d0 * 4096 + 1024), vtr(vp + d0 * 4096 + 1024 + 512));
            const bf16x8 v2 = cat8(vtr(vp + d0 * 4096 + 2048), vtr(vp + d0 * 4096 + 2048 + 512));
            const bf16x8 v3 = cat8(vtr(vp + d0 * 4096 + 3072), vtr(vp + d0 * 4096 + 3072 + 512));
            o[d0] = __builtin_amdgcn_mfma_f32_32x32x16_bf16(pa0, v0, o[d0], 0, 0, 0);
            o[d0] = __builtin_amdgcn_mfma_f32_32x32x16_bf16(pa1, v1, o[d0], 0, 0, 0);
            o[d0] = __builtin_amdgcn_mfma_f32_32x32x16_bf16(pa2, v2, o[d0], 0, 0, 0);
            o[d0] = __builtin_amdgcn_mfma_f32_32x32x16_bf16(pa3, v3, o[d0], 0, 0, 0);
        }
    }
#undef ATT_ISSUE
    lrun += __shfl_xor(lrun, 32);
    if (hi == 0) wsf[32 + r32] = frcp(lrun);
    LDS_WAIT();
    bf16_t* Ow = O + (rowbase + qw0) * 1024 + h * 128 + r32;
#pragma unroll
    for (int g4 = 0; g4 < 4; ++g4) { const f32x4 a4 = *(const LAS f32x4*)(wsf + 32 + 8 * g4 + 4 * hi);
#pragma unroll
        for (int j = 0; j < 4; ++j) { const int row = 8 * g4 + 4 * hi + j;
#pragma unroll
            for (int d = 0; d < 4; ++d) Ow[(long)row * 1024 + d * 32] = (bf16_t)(pk2(o[d][4 * g4 + j] * a4[j], 0.f) & 0xffffu); } }
}
}

namespace hg {
__device__ __forceinline__ void prefix(const float* logf_base, int k, int j, float (&lf)[16], float (&G)[16], float& gl, float& g31, LAS float* part) {
    float run = 0.f;
#pragma unroll
    for (int i = 0; i < 16; ++i) { lf[i] = logf_base[(size_t)(16 * j + i) * 1024 + k]; run += lf[i]; G[i] = run; }
    part[j * 128 + k] = run;
    LDS_WAIT(); __syncthreads();
    const float p0 = part[k], p1 = part[128 + k], p2 = part[256 + k], p3 = part[384 + k];
    const float off = (j > 0 ? p0 : 0.f) + (j > 1 ? p1 : 0.f) + (j > 2 ? p2 : 0.f);
#pragma unroll
    for (int i = 0; i < 16; ++i) G[i] += off;
    gl = (p0 + p1) + (p2 + p3); g31 = p0 + p1;
}
__device__ __forceinline__ int sub_off(int s, int c, int nrg) { return (((c >> 5) * nrg + (s >> 4)) << 10) + (s & 15) * 64 + (c & 31) * 2; }
__device__ __forceinline__ int swz_off(int row, int c) { return row * 256 + ((((c >> 3) ^ (row & 15))) << 4) + (c & 7) * 2; }

constexpr int LA_KD = 0, LA_V = 16384, LA_PART = 32768;
__device__ __forceinline__ void pass_a(const Ctx& F, int unit, const float* logf, const bf16_t* hgi, bf16_t* Sloc, float* glast) {
    LAS unsigned char* lds = F.lds; const int lane = F.lane, wid = F.wave, hi = lane >> 5;
    const int bh = unit >> 6, c = unit & 63, b = bh >> 3, h = bh & 7; const size_t row0 = (size_t)b * SEQ + c * 64;
    __syncthreads();
#pragma unroll
    for (int q = 0; q < 2; ++q) { const int pi = wid + 8 * q; glds16(hgi + (row0 + 16 * (pi & 3) + (lane >> 2)) * 1024 + h * 128 + (pi >> 2) * 32 + (lane & 3) * 8, lds + LA_V + pi * 1024); }
    const int k = F.tid & 127, j = F.tid >> 7;
    float lf[16], G[16], gl, g31;
    prefix(logf + row0 * 1024 + h * 128, k, j, lf, G, gl, g31, (LAS float*)(lds + LA_PART));
    if (j == 0) glast[(size_t)unit * 128 + k] = gl;
#pragma unroll
    for (int i = 0; i < 16; ++i) { const int s = 16 * j + i; const float kd = (1.f - fexp(lf[i])) * fexp(gl - G[i]);
        *(LAS bf16_t*)(lds + LA_KD + sub_off(s, k, 4)) = (bf16_t)(pk2(kd, 0.f) & 0xffffu); }
    VM_WAIT(); LDS_WAIT(); __syncthreads();
    const int kb = wid >> 1;
    const int lo = ((lane >> 4) & 1) * 32 + (lane & 3) * 8 + (4 * hi + ((lane & 15) >> 2)) * 64;
    bf16x8 af[4];
#pragma unroll
    for (int ks = 0; ks < 4; ++ks) af[ks] = cat8(vtr(lds + LA_KD + (kb * 4 + ks) * 1024 + lo), vtr(lds + LA_KD + (kb * 4 + ks) * 1024 + lo + 512));
#pragma unroll
    for (int q = 0; q < 2; ++q) { const int vb = (wid & 1) * 2 + q; f32x16 acc = (f32x16){};
#pragma unroll
        for (int ks = 0; ks < 4; ++ks) { const bf16x8 bfr = cat8(vtr(lds + LA_V + (vb * 4 + ks) * 1024 + lo), vtr(lds + LA_V + (vb * 4 + ks) * 1024 + lo + 512));
            acc = __builtin_amdgcn_mfma_f32_32x32x16_bf16(af[ks], bfr, acc, 0, 0, 0); }
        bf16_t* o = Sloc + (size_t)unit * 16384 + vb * 32 + (lane & 31);
#pragma unroll
        for (int r = 0; r < 16; ++r) o[(size_t)(32 * kb + crow(r, hi)) * 128] = (bf16_t)(pk2(acc[r], 0.f) & 0xffffu); }
}
__device__ __forceinline__ void pass_b(const Ctx& F, const bf16_t* Sloc, const float* glast, bf16_t* Sin) {
    for (int gid = F.vcu * NTHREADS + F.tid; gid < 16 * 8192; gid += F.G * NTHREADS) {
        const int bh = gid >> 13, e2 = gid & 8191, k = e2 >> 6; const size_t eo = (size_t)e2 * 2;
        float s0 = 0.f, s1 = 0.f;
#pragma unroll 8
        for (int c = 0; c < 64; ++c) { const size_t un = (size_t)(bh * 64 + c);
            *(unsigned*)(Sin + un * 16384 + eo) = pk2(s0, s1);
            const float d = fexp(glast[un * 128 + k]); const unsigned w = *(const unsigned*)(Sloc + un * 16384 + eo);
            s0 = d * s0 + bflo(w); s1 = d * s1 + bfhi(w); }
    }
}
constexpr int LC_QG = 0, LC_QR = 16384, LC_KR = 32768, LC_V = 49152, LC_S = 65536, LC_PART = 98304, LC_RED = 100352;
__device__ __forceinline__ void pass_c(const Ctx& F, int unit, const float* logf, const bf16_t* hgq, const bf16_t* hgi, const bf16_t* hgg, const bf16_t* Sin, const float* nw, bf16_t* mix) {
    LAS unsigned char* lds = F.lds; const int lane = F.lane, wid = F.wave, hi = lane >> 5, l31 = lane & 31;
    const int bh = unit >> 6, c = unit & 63, b = bh >> 3, h = bh & 7; const size_t row0 = (size_t)b * SEQ + c * 64;
    __syncthreads();
#pragma unroll
    for (int q = 0; q < 2; ++q) { const int pi = wid + 8 * q; glds16(hgi + (row0 + 16 * (pi & 3) + (lane >> 2)) * 1024 + h * 128 + (pi >> 2) * 32 + (lane & 3) * 8, lds + LC_V + pi * 1024); }
#pragma unroll
    for (int q = 0; q < 4; ++q) { const int pi = wid + 8 * q;
        glds16(Sin + (size_t)unit * 16384 + (size_t)(16 * (pi & 7) + (lane >> 2)) * 128 + (pi >> 3) * 32 + (lane & 3) * 8, lds + LC_S + pi * 1024); }
    const int k = F.tid & 127, j = F.tid >> 7;
    { float lf[16], G[16], gl, g31;
      prefix(logf + row0 * 1024 + h * 128, k, j, lf, G, gl, g31, (LAS float*)(lds + LC_PART));
#pragma unroll
      for (int i = 0; i < 16; ++i) { const int t = 16 * j + i; const float q = bf2f(hgq[(row0 + t) * 1024 + h * 128 + k]);
          const float qg = q * fexp(G[i]), qrr = q * fexp(G[i] - g31), kr = (1.f - fexp(lf[i])) * fexp(g31 - G[i]);
          const int so = swz_off(t, k);
          *(LAS bf16_t*)(lds + LC_QG + so) = (bf16_t)(pk2(qg, 0.f) & 0xffffu);
          *(LAS bf16_t*)(lds + LC_QR + so) = (bf16_t)(pk2(qrr, 0.f) & 0xffffu);
          *(LAS bf16_t*)(lds + LC_KR + so) = (bf16_t)(pk2(kr, 0.f) & 0xffffu); } }
    VM_WAIT(); LDS_WAIT(); __syncthreads();
    const int tb = wid >> 2, vb = wid & 3;
    f32x16 sc0 = (f32x16){}, sc1 = (f32x16){};
    const int trow = 32 * tb + l31;
#pragma unroll
    for (int kk = 0; kk < 8; ++kk) { const int ch = 2 * kk + hi;
        const bf16x8 bq = *(const LAS bf16x8*)(lds + LC_QR + trow * 256 + ((ch ^ (trow & 15)) << 4));
        const bf16x8 a0 = *(const LAS bf16x8*)(lds + LC_KR + l31 * 256 + ((ch ^ (l31 & 15)) << 4));
        sc0 = __builtin_amdgcn_mfma_f32_32x32x16_bf16(a0, bq, sc0, 0, 0, 0);
        if (tb == 1) { const int sr = 32 + l31; const bf16x8 a1 = *(const LAS bf16x8*)(lds + LC_KR + sr * 256 + ((ch ^ (sr & 15)) << 4));
            sc1 = __builtin_amdgcn_mfma_f32_32x32x16_bf16(a1, bq, sc1, 0, 0, 0); } }
#pragma unroll
    for (int r = 0; r < 16; ++r) { const bool keep = crow(r, hi) <= l31; if (tb == 0) { if (!keep) sc0[r] = 0.f; } else { if (!keep) sc1[r] = 0.f; } }
    f32x16 o = (f32x16){};
    const int lo_p = ((lane >> 4) & 1) * 32 + (lane & 3) * 8 + (4 * hi + ((lane & 15) >> 2)) * 64;
    const int lo_n = ((lane >> 4) & 1) * 32 + (lane & 3) * 8 + (8 * hi + ((lane & 15) >> 2)) * 64;
    { const bf16x8 pa0 = pack8(sc0, 0), pa1 = pack8(sc0, 8);
      const bf16x8 v0 = cat8(vtr(lds + LC_V + (vb * 4 + 0) * 1024 + lo_p), vtr(lds + LC_V + (vb * 4 + 0) * 1024 + lo_p + 512));
      const bf16x8 v1 = cat8(vtr(lds + LC_V + (vb * 4 + 1) * 1024 + lo_p), vtr(lds + LC_V + (vb * 4 + 1) * 1024 + lo_p + 512));
      o = __builtin_amdgcn_mfma_f32_32x32x16_bf16(pa0, v0, o, 0, 0, 0); o = __builtin_amdgcn_mfma_f32_32x32x16_bf16(pa1, v1, o, 0, 0, 0);
      if (tb == 1) { const bf16x8 pb0 = pack8(sc1, 0), pb1 = pack8(sc1, 8);
          const bf16x8 v2 = cat8(vtr(lds + LC_V + (vb * 4 + 2) * 1024 + lo_p), vtr(lds + LC_V + (vb * 4 + 2) * 1024 + lo_p + 512));
          const bf16x8 v3 = cat8(vtr(lds + LC_V + (vb * 4 + 3) * 1024 + lo_p), vtr(lds + LC_V + (vb * 4 + 3) * 1024 + lo_p + 512));
          o = __builtin_amdgcn_mfma_f32_32x32x16_bf16(pb0, v2, o, 0, 0, 0); o = __builtin_amdgcn_mfma_f32_32x32x16_bf16(pb1, v3, o, 0, 0, 0); } }
#pragma unroll
    for (int kk = 0; kk < 8; ++kk) { const int ch = 2 * kk + hi;
        const bf16x8 aq = *(const LAS bf16x8*)(lds + LC_QG + trow * 256 + ((ch ^ (trow & 15)) << 4));
        const bf16x8 bs = cat8(vtr(lds + LC_S + (vb * 8 + kk) * 1024 + lo_n), vtr(lds + LC_S + (vb * 8 + kk) * 1024 + lo_n + 256));
        o = __builtin_amdgcn_mfma_f32_32x32x16_bf16(aq, bs, o, 0, 0, 0); }
    LAS float* red = (LAS float*)(lds + LC_RED);
#pragma unroll
    for (int r = 0; r < 16; ++r) { float s = o[r] * o[r];
        s += __shfl_xor(s, 1); s += __shfl_xor(s, 2); s += __shfl_xor(s, 4); s += __shfl_xor(s, 8); s += __shfl_xor(s, 16);
        if (l31 == 0) red[(32 * tb + crow(r, hi)) * 4 + vb] = s; }
    LDS_WAIT(); __syncthreads();
    const int v = 32 * vb + l31; const float nwv = nw[v];
#pragma unroll
    for (int r = 0; r < 16; ++r) { const int t = 32 * tb + crow(r, hi); const f32x4 p = *(const LAS f32x4*)(red + t * 4);
        const float ri = __builtin_amdgcn_rsqf(((p[0] + p[1]) + (p[2] + p[3])) * (1.f / 128.f) + EPS);
        const float gv = bf2f(hgg[(row0 + t) * 1024 + h * 128 + v]);
        const float out = o[r] * ri * nwv * gv * frcp(1.f + fexp(-gv));
        mix[(row0 + t) * DM + 1024 + h * 128 + v] = (bf16_t)(pk2(out, 0.f) & 0xffffu); }
}
}

__device__ __forceinline__ void da_combine(const Ctx& F, const Args& a, const bf16_t* O, bf16_t* mix) {
    const int lane = F.lane;
    float d1 = a.lam_q1[lane] * a.lam_k1[lane], d2 = a.lam_q2[lane] * a.lam_k2[lane];
    const float lam = fexp(wave_sum(d1)) - fexp(wave_sum(d2)) + 0.2f;
    const int gw = F.vcu * NWAVES + F.wave, NGW = F.G * NWAVES;
    float w[16];
#pragma unroll
    for (int i = 0; i < 16; ++i) w[i] = a.da_subln_w[(lane & 7) * 16 + i] * 0.8f;
    for (int m = gw; m < MROWS; m += NGW) {
        const u32x4 a0 = *(const u32x4*)(O + (size_t)m * 1024 + lane * 16), a1 = *(const u32x4*)(O + (size_t)m * 1024 + lane * 16 + 8);
        const u32x4 b0 = *(const u32x4*)(O + SEG + (size_t)m * 1024 + lane * 16), b1 = *(const u32x4*)(O + SEG + (size_t)m * 1024 + lane * 16 + 8);
        float v[16]; float ss = 0.f;
#pragma unroll
        for (int i = 0; i < 4; ++i) { v[2 * i] = bflo(a0[i]) - lam * bflo(b0[i]); v[2 * i + 1] = bfhi(a0[i]) - lam * bfhi(b0[i]);
            v[8 + 2 * i] = bflo(a1[i]) - lam * bflo(b1[i]); v[8 + 2 * i + 1] = bfhi(a1[i]) - lam * bfhi(b1[i]); }
#pragma unroll
        for (int i = 0; i < 16; ++i) ss += v[i] * v[i];
        ss += __shfl_xor(ss, 1); ss += __shfl_xor(ss, 2); ss += __shfl_xor(ss, 4);
        const float r = __builtin_amdgcn_rsqf(ss * (1.f / 128.f) + EPS);
        u32x4 o0, o1;
#pragma unroll
        for (int i = 0; i < 4; ++i) { o0[i] = pk2(v[2 * i] * r * w[2 * i], v[2 * i + 1] * r * w[2 * i + 1]); o1[i] = pk2(v[8 + 2 * i] * r * w[8 + 2 * i], v[8 + 2 * i + 1] * r * w[8 + 2 * i + 1]); }
        *(u32x4*)(mix + (size_t)m * DM + lane * 16) = o0; *(u32x4*)(mix + (size_t)m * DM + lane * 16 + 8) = o1;
    }
}

__device__ __forceinline__ void conv_fixup(const Ctx& F, const Args& a, const bf16_t* Y4, bf16_t* Gm) {
    const int total = 32 * 2 * DFF;
    for (int i = F.vcu * NTHREADS + F.tid; i < total; i += F.G * NTHREADS) {
        const int c = i % DFF, rr = (i / DFF) & 1, pm = i / (2 * DFF);
        if ((pm & 15) == 0) continue;
        float u2[2];
#pragma unroll
        for (int bj = 0; bj < 2; ++bj) { const int cc = bj * DFF + c;
            const float ym2 = bf2f(Y4[((size_t)(pm - 1) * 4 + 2) * (2 * DFF) + cc]), ym1 = bf2f(Y4[((size_t)(pm - 1) * 4 + 3) * (2 * DFF) + cc]);
            const float y0 = bf2f(Y4[((size_t)pm * 4 + 0) * (2 * DFF) + cc]), y1 = bf2f(Y4[((size_t)pm * 4 + 1) * (2 * DFF) + cc]);
            const float w0 = a.conv_w[cc], w1 = a.conv_w[2 * DFF + cc], w2 = a.conv_w[4 * DFF + cc], bb = a.conv_b[cc];
            u2[bj] = rr == 0 ? bb + w0 * ym2 + w1 * ym1 + w2 * y0 : bb + w0 * ym1 + w1 * y0 + w2 * y1; }
        const float gv = u2[0] * frcp(1.f + fexp(-u2[0])) * u2[1];
        Gm[(size_t)(pm * 256 + rr) * DFF + c] = (bf16_t)(pk2(gv, 0.f) & 0xffffu);
    }
}
__device__ __forceinline__ void final_norm(const Ctx& F, const Args& a, const float* rss, const float* xin, float* out) {
    const int gw = F.vcu * NWAVES + F.wave, NGW = F.G * NWAVES, lane = F.lane;
    for (int m = gw; m < MROWS; m += NGW) {
        const float r = pg8::row_rinv(rss, m);
        const f32x4* xr = (const f32x4*)(xin + (size_t)m * DM) + lane; f32x4* orow = (f32x4*)(out + (size_t)m * DM) + lane; const f32x4* gr = (const f32x4*)a.final_norm_w + lane;
#pragma unroll
        for (int j = 0; j < 8; ++j) { const f32x4 v = xr[64 * j], gq = gr[64 * j]; orow[64 * j] = v * gq * r; }
    }
}

constexpr int N_PHASES = 12;
template <int PM> __global__ void __launch_bounds__(NTHREADS, 2) hymba_fwd(Args args) {
    extern __shared__ __attribute__((aligned(16))) unsigned char lds_raw[];
    Ctx F0; F0.lds = (LAS unsigned char*)lds_raw;
    F0.tid = threadIdx.x; F0.lane = F0.tid & 63; F0.wave = __builtin_amdgcn_readfirstlane(F0.tid >> 6);
    F0.G = gridDim.x; { const int bx = blockIdx.x; F0.vcu = (F0.G % 8 == 0) ? (bx % 8) * (F0.G / 8) + bx / 8 : bx; }
    unsigned char* ws = args.ws;
    volatile LAS unsigned* MISC = (volatile LAS unsigned*)(F0.lds + MISC_OFF);
    if (F0.tid < 32) MISC[F0.tid] = 0u;
    __syncthreads();
    XcdBarrier bar; bar.bar = (unsigned*)(ws + WS_CTL) + CW_BAR; bar.x = 0; bar.st = nullptr;
    const int lo = args.ph_lo, hi = args.ph_hi;
    if (hi - lo > 1) bar = xcd_barrier_post((unsigned*)(ws + WS_CTL) + CW_BAR, MISC + 8);
#define IN(k) ((((PM) >> (k)) & 1) && lo <= (k) && (k) < hi)
#define SEAM(k) do { if (IN(k) && IN((k) + 1)) xcd_barrier(bar); } while (0)
#ifndef DUP_MASK
#define DUP_MASK 0
#endif
#define NREP(k) ((((DUP_MASK) >> (k)) & 1) ? 2 : 1)
#define REP(k) for (int rep_ = 0; rep_ < NREP(k); ++rep_, (rep_ < NREP(k) ? xcd_barrier(bar) : (void)0))
    const int bx = (int)blockIdx.x, G = F0.G;
    bf16_t* const A1 = (bf16_t*)(ws + WS_A1); bf16_t* const A2 = (bf16_t*)(ws + WS_A2); bf16_t* const A3 = (bf16_t*)(ws + WS_A3); float* const LOGF = (float*)(ws + WS_A4);
    bf16_t* const SLOC = (bf16_t*)((unsigned char*)args.out + OUT_SLOC); bf16_t* const OB = (bf16_t*)((unsigned char*)args.out + OUT_O);
    float* const GLAST = (float*)(ws + WS_GLAST);
    float* const X1 = (float*)(ws + WS_A3);
    float* const X3 = (float*)(ws + WS_WIN);

    const bool defer = (G == 256);
    REP(0) if (IN(0)) { const Ctx F = fresh(F0); p0_prologue(F, args, defer); }
    SEAM(0);
    REP(1) if (IN(1)) { const Ctx F = fresh(F0);
        { pg8::Gemm g{A1, (const bf16_t*)(ws + WS_WIN), DM, DM, DM, 0, 0, 0, 0, 256L * DM, 128L * DM, 0}; pg8::Order S; S.init(MROWS / 256, DIN / 256, 1, G, bx);
          pg8::EpiInProj E{A2, A3, LOGF, args.hg_lb_raw};
          pg8::gemm_phase<pg8::EpiInProj, true>(F.lds, g, S, E); }
        { pg8::Gemm g{(const bf16_t*)(ws + WS_MK), (const bf16_t*)(ws + WS_WMKV), DM, DM, DM, 0, 0, 0, 0, 256L * DM, 128L * DM, 0}; pg8::Order S; S.init(2, 16, 1, G, (bx + G / 2) % G);
          pg8::EpiBf16 E{(bf16_t*)(ws + WS_KVMEM), 2 * DM, 0, 0};
          pg8::gemm_phase<pg8::EpiBf16, true>(F.lds, g, S, E); }
        if (defer && bx >= 160) cvt_p1(F, args, (bx - 160) * NWAVES + F.wave, 96 * NWAVES);
    }
    SEAM(1);
    REP(2) if (IN(2)) { const Ctx F = fresh(F0);
        { const int bhm = F.vcu >> 3, s = F.vcu & 7;
          if (G == 256) { const int b = bhm >> 4, h = (bhm >> 1) & 7, map = bhm & 1;
              att::unit(F, b, h, map, 15 - s, A2, A2 + SEG, A2 + 2 * SEG, OB + (size_t)map * SEG, args.rel_bias);
              att::unit(F, b, h, map, s, A2, A2 + SEG, A2 + 2 * SEG, OB + (size_t)map * SEG, args.rel_bias);
          } else { for (int un = F.vcu; un < 512; un += G) { const int bhm2 = un >> 4, qb = un & 15; att::unit(F, bhm2 >> 4, (bhm2 >> 1) & 7, bhm2 & 1, qb, A2, A2 + SEG, A2 + 2 * SEG, OB + (size_t)(bhm2 & 1) * SEG, args.rel_bias); } } }
        for (int un = F.vcu; un < 1024; un += G) hg::pass_a(F, un, LOGF, A3 + SEG, SLOC, GLAST);
        VM_WAIT(); __syncthreads();
        { pg8::Gemm g{(const bf16_t*)(ws + WS_KVMEM), (const bf16_t*)(ws + WS_WMQ), 2 * DM, DM, 512, 256L * 4096, 512, 0, 512, 256L * DM, 128L * DM, 0}; pg8::Order S; S.init(1, 8, 8, G, bx);
          pg8::EpiBf16 E{(bf16_t*)(ws + WS_WKT), DM, 1024L * DM, 256L * DM};
          pg8::gemm_phase<pg8::EpiBf16, true>(F.lds, g, S, E); }
        { pg8::Gemm g{(const bf16_t*)(ws + WS_WMO), (const bf16_t*)(ws + WS_KVMEM) + DM, DM, 2 * DM, 512, 0, 512, 256L * 4096, 512, 256L * 4096, 128L * 4096, 0}; pg8::Order S; S.init(8, 1, 8, G, (bx + 64) % G);
          pg8::EpiBf16 E{(bf16_t*)(ws + WS_VWT), 1024, (long)DM * 1024, 256};
          pg8::gemm_phase<pg8::EpiBf16, true>(F.lds, g, S, E); }
    }
    SEAM(2);
    REP(3) if (IN(3)) { const Ctx F = fresh(F0); hg::pass_b(F, SLOC, GLAST, A1); }
    SEAM(3);
    REP(4) if (IN(4)) { const Ctx F = fresh(F0);
        for (int un = F.vcu; un < 1024; un += G) hg::pass_c(F, un, LOGF, A3, A3 + SEG, A3 + 2 * SEG, A1, args.hg_norm_w, A2);
        da_combine(F, args, OB, A2);
    }
    SEAM(4);
    REP(5) if (IN(5)) { const Ctx F = fresh(F0);
        pg8::Gemm g{A2, (const bf16_t*)(ws + WS_WOUT), DM, DM, DM, 0, 0, 0, 0, 256L * DM, 128L * DM, 0}; pg8::Order S; S.init(MROWS / 256, DM / 256, 1, G, bx);
        pg8::EpiResid<true> E{args.x, X1, A1, (float*)(ws + WS_RSS1)};
        pg8::gemm_phase<pg8::EpiResid<true>, false>(F.lds, g, S, E);
    }
    SEAM(5);
    REP(6) if (IN(6)) { const Ctx F = fresh(F0);
        pg8::Gemm g{A1, (const bf16_t*)(ws + WS_WKT), DM, DM, DM, 0, 0, 0, 0, 256L * DM, 128L * DM, 1024L * DM}; pg8::Order S; S.init(MROWS / 256, 4, 1, G, bx);
        pg8::EpiSoftmax E{(const float*)(ws + WS_RSS1), A2};
        pg8::gemm_phase<pg8::EpiSoftmax, false>(F.lds, g, S, E);
        if (defer && bx >= 128) cvt_up(F, args, (bx - 128) * NWAVES + F.wave, 128 * NWAVES);
    }
    SEAM(6);
    REP(7) if (IN(7)) { const Ctx F = fresh(F0);
        pg8::Gemm g{A2, (const bf16_t*)(ws + WS_VWT), 1024, 1024, 1024, 0, 0, 0, 0, 256L * 1024, 128L * 1024, (long)DM * 1024}; pg8::Order S; S.init(MROWS / 256, DM / 256, 1, G, bx);
        pg8::EpiResid<true> E{X1, args.out, A1, (float*)(ws + WS_RSS2)};
        pg8::gemm_phase<pg8::EpiResid<true>, false>(F.lds, g, S, E);
    }
    SEAM(7);
    REP(8) if (IN(8)) { const Ctx F = fresh(F0);
        pg8::Gemm g{A1, (const bf16_t*)(ws + WS_WUP), DM, DM, DM, 0, 0, 0, 0, 128L * DM, (long)DFF * DM, 0}; pg8::Order S; S.init(MROWS / 256, DFF / 128, 1, G, bx);
        pg8::EpiUp E{(const float*)(ws + WS_RSS2), args.conv_w, args.conv_b, (bf16_t*)(ws + WS_G), (bf16_t*)(ws + WS_Y4)};
        pg8::gemm_phase<pg8::EpiUp, true>(F.lds, g, S, E);
        if (defer && bx >= 128) cvt_down(F, args, (bx - 128) * NWAVES + F.wave, 128 * NWAVES);
    }
    SEAM(8);
    REP(9) if (IN(9)) { const Ctx F = fresh(F0); conv_fixup(F, args, (const bf16_t*)(ws + WS_Y4), (bf16_t*)(ws + WS_G)); }
    SEAM(9);
    REP(10) if (IN(10)) { const Ctx F = fresh(F0);
        pg8::Gemm g{(const bf16_t*)(ws + WS_G), (const bf16_t*)(ws + WS_WDOWN), DFF, DFF, DFF, 0, 0, 0, 0, 256L * DFF, 128L * DFF, 0}; pg8::Order S; S.init(MROWS / 256, DM / 256, 1, G, bx);
        pg8::EpiResid<false> E{args.out, X3, nullptr, (float*)(ws + WS_RSS3)};
        pg8::gemm_phase<pg8::EpiResid<false>, false>(F.lds, g, S, E);
    }
    SEAM(10);
    REP(11) if (IN(11)) { const Ctx F = fresh(F0); final_norm(F, args, (const float*)(ws + WS_RSS3), X3, args.out); }
#undef IN
#undef SEAM
}

typedef void (*kern_t)(Args);
#ifndef PHASE_MASK
#define PHASE_MASK 0xFFF
#endif
static kern_t phase_kernel(int p) {
    switch (p) {
        case 0: return hymba_fwd<1 << 0>; case 1: return hymba_fwd<1 << 1>; case 2: return hymba_fwd<1 << 2>; case 3: return hymba_fwd<1 << 3>;
        case 4: return hymba_fwd<1 << 4>; case 5: return hymba_fwd<1 << 5>; case 6: return hymba_fwd<1 << 6>; case 7: return hymba_fwd<1 << 7>;
        case 8: return hymba_fwd<1 << 8>; case 9: return hymba_fwd<1 << 9>; case 10: return hymba_fwd<1 << 10>; default: return hymba_fwd<1 << 11>;
    }
}
extern "C" void kernel_launch(void* const* d_in, const int* in_sizes, int n_in, void* d_out, int out_size, void* d_ws, size_t ws_size, hipStream_t stream) {
    static int grid = 0;
    if (grid == 0) {
        if (n_in != 24 || in_sizes[0] != MROWS * DM || out_size != MROWS * DM || ws_size < WS_END) {
            fprintf(stderr, "kernel_launch: unexpected problem (n_in %d, in0 %d, out %d, ws %zu)\n", n_in, n_in > 0 ? in_sizes[0] : -1, out_size, ws_size); grid = -1; return; }
        int dev = 0, cus = 0, per_cu = 0;
        if (hipGetDevice(&dev) != hipSuccess || hipDeviceGetAttribute(&cus, hipDeviceAttributeMultiprocessorCount, dev) != hipSuccess) { grid = -1; return; }
        bool ok = true;
        if (MK_N_LAUNCHES == 1) {
            ok = hipFuncSetAttribute((const void*)hymba_fwd<PHASE_MASK>, hipFuncAttributeMaxDynamicSharedMemorySize, LDS_BYTES) == hipSuccess;
            if (hipOccupancyMaxActiveBlocksPerMultiprocessor(&per_cu, (const void*)hymba_fwd<PHASE_MASK>, NTHREADS, LDS_BYTES) != hipSuccess || per_cu < 1) { fprintf(stderr, "kernel_launch: occupancy query says %d\n", per_cu); }
        } else {
            for (int p = 0; p < N_PHASES; ++p) ok = ok && hipFuncSetAttribute((const void*)phase_kernel(p), hipFuncAttributeMaxDynamicSharedMemorySize, LDS_BYTES) == hipSuccess;
        }
        (void)hipGetLastError();
        if (!ok) { fprintf(stderr, "kernel_launch: hipFuncSetAttribute failed\n"); grid = -1; return; }
        grid = cus;
        if (grid != 256) fprintf(stderr, "kernel_launch: %d CUs; this build assumes 256\n", grid);
    }
    if (grid < 0) return;
    (void)hipMemsetAsync((char*)d_ws + WS_CTL, 0, CTL_ZERO_BYTES, stream);
    Args a{};
    const float** ap = (const float**)&a;
    for (int i = 0; i < 24; ++i) ap[i] = (const float*)d_in[i];
    a.out = (float*)d_out; a.ws = (unsigned char*)d_ws;
    if (MK_N_LAUNCHES == 1) { a.ph_lo = 0; a.ph_hi = N_PHASES; hipLaunchKernelGGL(hymba_fwd<PHASE_MASK>, dim3(grid), dim3(NTHREADS), LDS_BYTES, stream, a); }
    else { for (int p = 0; p < N_PHASES; ++p) { a.ph_lo = p; a.ph_hi = p + 1; hipLaunchKernelGGL(phase_kernel(p), dim3(grid), dim3(NTHREADS), LDS_BYTES, stream, a); } }
}
```
